# Optimizing an MI355X kernel written in HIP

```python
import jax
import jax.numpy as jnp
from jax import lax
import numpy as np

D_MODEL = 1024
BATCH = 2
SEQ = 8192
DEPTH = 2

GRID_W = 64
CTX_LEN = 256
N_EVEN = (DEPTH + 1) // 2
N_ODD = DEPTH // 2
EPS = 1e-6
N_MOD = 9
D_FF = 2816
FFN_RESIDUAL = 0.5

MLA_HEADS = 8
MLA_Q_RANK = 384
MLA_KV_RANK = 256
MLA_NOPE = 64
MLA_ROPE = 32
MLA_V = 64
MLA_QK = MLA_NOPE + MLA_ROPE
ROPE_AXIS_DIM = MLA_ROPE // 2
ROPE_BASE = 10000.0
Q_BLOCK = 128

MLSTM_HEADS = 4
MLSTM_DH = 128
MLSTM_WIDTH = MLSTM_HEADS * MLSTM_DH
MLSTM_CHUNK = 64

MIX_WIDTH = MLA_HEADS * MLA_V + MLSTM_WIDTH
EVEN_SPLITS = (MLA_Q_RANK, MLA_KV_RANK, MLA_ROPE, MLSTM_WIDTH, MLSTM_WIDTH, MLSTM_WIDTH, MLSTM_WIDTH, 4 * MLSTM_HEADS)
IN_EVEN = MLA_Q_RANK + MLA_KV_RANK + MLA_ROPE + 4 * MLSTM_WIDTH + 4 * MLSTM_HEADS

RNN_WIDTH = 1024
RNN_BLOCKS = 8
RNN_BLOCK_DIM = RNN_WIDTH // RNN_BLOCKS
CONV_W = 4
CONV_PAD_L = CONV_W // 2
CONV_PAD_R = CONV_W - 1 - CONV_PAD_L
LRU_C = 8.0

kernel_name = 'hybrid_mla_mlstm_rglru_prefix_block'


def rms_norm(x, g):
    xf = x.astype(jnp.float32)
    y = xf * lax.rsqrt(jnp.mean(xf * xf, axis=-1, keepdims=True) + EPS)
    return (y * g.astype(jnp.float32)).astype(x.dtype)


def ada_params(cond, w, b):
    m = jax.nn.silu(cond) @ w + b
    return jnp.split(m, N_MOD, axis=-1)


def modulate(h, shift, scale):
    return h * (1.0 + scale) + shift


def swiglu(h, w_gate, w_up, w_down):
    return (jax.nn.silu(h @ w_gate) * (h @ w_up)) @ w_down


def split_cols(p, sizes):
    idx, acc = [], 0
    for s in sizes[:-1]:
        acc += s
        idx.append(acc)
    return jnp.split(p, idx, axis=-1)


def axial_rope_tables(n_rows):
    rows = jnp.repeat(jnp.arange(n_rows), GRID_W)
    cols = jnp.tile(jnp.arange(GRID_W), n_rows)
    inv = ROPE_BASE ** (-jnp.arange(0, ROPE_AXIS_DIM, 2, dtype=jnp.float32) / ROPE_AXIS_DIM)
    ang = jnp.stack([rows, cols], axis=-1).astype(jnp.float32)[..., None] * inv
    return jnp.cos(ang), jnp.sin(ang)


def apply_axial_rope(x, cos, sin):
    shp = x.shape
    xr = x.astype(jnp.float32).reshape(shp[:-1] + (2, 2, ROPE_AXIS_DIM // 2))
    x1, x2 = xr[..., 0, :], xr[..., 1, :]
    out = jnp.stack([x1 * cos - x2 * sin, x2 * cos + x1 * sin], axis=-2)
    return out.reshape(shp).astype(x.dtype)


def mla_qkv(c_q, c_kv, k_rope, cq_g, w_uq, ckv_g, w_ukv, q_g, k_g, cos, sin):
    B, T, _ = c_q.shape
    q = (rms_norm(c_q, cq_g) @ w_uq).reshape(B, T, MLA_HEADS, MLA_QK)
    kv = (rms_norm(c_kv, ckv_g) @ w_ukv).reshape(B, T, MLA_HEADS, MLA_NOPE + MLA_V)
    q_nope = rms_norm(q[..., :MLA_NOPE], q_g[:MLA_NOPE])
    q_rope = rms_norm(q[..., MLA_NOPE:], q_g[MLA_NOPE:])
    k_nope = rms_norm(kv[..., :MLA_NOPE], k_g[:MLA_NOPE])
    k_rope = rms_norm(k_rope, k_g[MLA_NOPE:])
    v = kv[..., MLA_NOPE:]
    if cos is not None:
        q_rope = apply_axial_rope(q_rope, cos[:, None], sin[:, None])
        k_rope = apply_axial_rope(k_rope, cos, sin)
    k_rope = jnp.broadcast_to(k_rope[:, :, None, :], (B, T, MLA_HEADS, MLA_ROPE))
    q = jnp.concatenate([q_nope, q_rope], axis=-1).transpose(0, 2, 1, 3)
    k = jnp.concatenate([k_nope, k_rope], axis=-1).transpose(0, 2, 1, 3)
    return q, k, v.transpose(0, 2, 1, 3)


def attend(q, k, v):
    s = jnp.einsum('bhqd,bhkd->bhqk', q, k, preferred_element_type=jnp.float32) * (MLA_QK ** -0.5)
    p = jax.nn.softmax(s, axis=-1).astype(v.dtype)
    return jnp.einsum('bhqk,bhkd->bhqd', p, v)


def blocked_attention(q, k, v):
    B, H, T, dq = q.shape
    qb = jnp.moveaxis(q.reshape(B, H, T // Q_BLOCK, Q_BLOCK, dq), 2, 0)
    out = lax.map(lambda qi: attend(qi, k, v), qb)
    return jnp.moveaxis(out, 0, 2).reshape(B, H, T, -1)


def heads_to_tokens(a):
    B, H, T, d = a.shape
    return a.transpose(0, 2, 1, 3).reshape(B, T, H * d)


def mlstm_chunkwise(q, k, v, log_i, log_f, state0):
    B, H, T, dh = q.shape
    L = MLSTM_CHUNK
    nc = T // L

    def chunks(a):
        return jnp.moveaxis(a.reshape((B, H, nc, L) + a.shape[3:]), 2, 0)

    lower = jnp.tril(jnp.ones((L, L), dtype=bool))

    def step(carry, inp):
        C, n, m = carry
        qc, kc, vc, ic, fc = inp
        b = jnp.cumsum(fc, axis=-1)
        d = jnp.where(lower, b[..., :, None] - b[..., None, :] + ic[..., None, :], -jnp.inf)
        m_t = jnp.maximum(b + m[..., None], jnp.max(d, axis=-1))
        w_intra = jnp.exp(d - m_t[..., None])
        w_inter = jnp.exp(b + m[..., None] - m_t)
        s = jnp.einsum('bhtd,bhsd->bhts', qc, kc) * w_intra
        num = jnp.einsum('bhts,bhsd->bhtd', s, vc) + w_inter[..., None] * jnp.einsum('bhvk,bhtk->bhtv', C, qc)
        den = jnp.sum(s, axis=-1) + w_inter * jnp.einsum('bhk,bhtk->bht', n, qc)
        h = num / jnp.maximum(jnp.abs(den), jnp.exp(-m_t))[..., None]
        b_end = b[..., -1]
        g = b_end[..., None] - b + ic
        m_new = jnp.maximum(b_end + m, jnp.max(g, axis=-1))
        w_s = jnp.exp(g - m_new[..., None])
        decay = jnp.exp(b_end + m - m_new)
        C_new = decay[..., None, None] * C + jnp.einsum('bhs,bhsv,bhsk->bhvk', w_s, vc, kc)
        n_new = decay[..., None] * n + jnp.einsum('bhs,bhsk->bhk', w_s, kc)
        return (C_new, n_new, m_new), h

    state, hs = lax.scan(step, state0, (chunks(q), chunks(k), chunks(v), chunks(log_i), chunks(log_f)))
    return jnp.moveaxis(hs, 0, 2).reshape(B, H, T, dh), state


def mlstm_mixer(qx, kx, vx, ox, gx, qc, kc, vc, oc, gc, gate_b, out_g, need_ctx):
    def heads(a):
        B, T, _ = a.shape
        return a.astype(jnp.float32).reshape(B, T, MLSTM_HEADS, MLSTM_DH).transpose(0, 2, 1, 3)

    def gates(g):
        B, T, _ = g.shape
        g = (g.astype(jnp.float32) + gate_b.astype(jnp.float32)).reshape(B, T, 4, MLSTM_HEADS).transpose(2, 0, 3, 1)
        return g[0], jax.nn.log_sigmoid(g[1]), g[2], jax.nn.log_sigmoid(g[3])

    def rev(a):
        return jnp.flip(a, axis=2)

    def readout(h, o):
        B, H, T, d = h.shape
        hn = rms_norm(h.transpose(0, 2, 1, 3), out_g.reshape(MLSTM_HEADS, MLSTM_DH))
        gate = jax.nn.sigmoid(o.astype(jnp.float32)).reshape(B, T, H, d)
        return (hn * gate).reshape(B, T, H * d).astype(o.dtype)

    k_scale = MLSTM_DH ** -0.5
    Qx, Kx, Vx = heads(qx), heads(kx) * k_scale, heads(vx)
    Qc, Kc, Vc = heads(qc), heads(kc) * k_scale, heads(vc)
    ifx, lffx, ibx, lfbx = gates(gx)
    ifc, lffc, ibc, lfbc = gates(gc)
    B = qx.shape[0]
    zero = (jnp.zeros((B, MLSTM_HEADS, MLSTM_DH, MLSTM_DH), jnp.float32),
            jnp.zeros((B, MLSTM_HEADS, MLSTM_DH), jnp.float32),
            jnp.zeros((B, MLSTM_HEADS), jnp.float32))
    hcf, st_f = mlstm_chunkwise(Qc, Kc, Vc, ifc, lffc, zero)
    hcb, st_b = mlstm_chunkwise(rev(Qc), rev(Kc), rev(Vc), rev(ibc), rev(lfbc), zero)
    hxf, _ = mlstm_chunkwise(Qx, Kx, Vx, ifx, lffx, st_f)
    hxb, _ = mlstm_chunkwise(rev(Qx), rev(Kx), rev(Vx), rev(ibx), rev(lfbx), st_b)
    out_x = readout(hxf + rev(hxb), ox)
    out_c = readout(hcf + rev(hcb), oc) if need_ctx else None
    return out_x, out_c


def even_mixer(hx, hc, w_in, w_out, cq_g, w_uq, ckv_g, w_ukv, q_g, k_g, gate_b, out_g, cos, sin, need_ctx):
    cq_x, ckv_x, kr_x, mq_x, mk_x, mv_x, mo_x, mg_x = split_cols(hx @ w_in, EVEN_SPLITS)
    cq_c, ckv_c, kr_c, mq_c, mk_c, mv_c, mo_c, mg_c = split_cols(hc @ w_in, EVEN_SPLITS)
    q_x, k_x, v_x = mla_qkv(cq_x, ckv_x, kr_x, cq_g, w_uq, ckv_g, w_ukv, q_g, k_g, cos, sin)
    q_c, k_c, v_c = mla_qkv(cq_c, ckv_c, kr_c, cq_g, w_uq, ckv_g, w_ukv, q_g, k_g, None, None)
    k_all = jnp.concatenate([k_c, k_x], axis=2)
    v_all = jnp.concatenate([v_c, v_x], axis=2)
    att_x = heads_to_tokens(blocked_attention(q_x, k_all, v_all))
    ml_x, ml_c = mlstm_mixer(mq_x, mk_x, mv_x, mo_x, mg_x, mq_c, mk_c, mv_c, mo_c, mg_c, gate_b, out_g, need_ctx)
    y_x = jnp.concatenate([att_x, ml_x], axis=-1) @ w_out
    y_c = None
    if need_ctx:
        att_c = heads_to_tokens(attend(q_c, k_c, v_c))
        y_c = jnp.concatenate([att_c, ml_c], axis=-1) @ w_out
    return y_x, y_c


def short_conv(u, w, b):
    out = lax.conv_general_dilated(u, w[:, None, :].astype(u.dtype), window_strides=(1,),
                                   padding=[(CONV_PAD_L, CONV_PAD_R)],
                                   dimension_numbers=('NWC', 'WIO', 'NWC'),
                                   feature_group_count=u.shape[-1])
    return out + b


def _lin_combine(e1, e2):
    a1, b1 = e1
    a2, b2 = e2
    return a1 * a2, a2 * b1 + b2


def rglru_scan(u, w_a, b_a, w_x, b_x, lam, h0):
    B, T, R = u.shape
    uf = u.astype(jnp.float32)
    ub = uf.reshape(B, T, RNN_BLOCKS, RNN_BLOCK_DIM)
    r = jax.nn.sigmoid(jnp.einsum('btnd,nde->btne', ub, w_a.astype(jnp.float32)).reshape(B, T, R) + b_a.astype(jnp.float32))
    i = jax.nn.sigmoid(jnp.einsum('btnd,nde->btne', ub, w_x.astype(jnp.float32)).reshape(B, T, R) + b_x.astype(jnp.float32))
    log_a = -LRU_C * r * jax.nn.softplus(-lam.astype(jnp.float32))
    a = jnp.exp(log_a)
    inp = jnp.sqrt(-jnp.expm1(2.0 * log_a)) * (i * uf)
    a_cum, h_part = lax.associative_scan(_lin_combine, (a, inp), axis=1)
    h = a_cum * h0[:, None, :] + h_part
    return h, h[:, -1]


def odd_mixer(hx, hc, w_in, conv_w, conv_b, w_a, b_a, w_x, b_x, lam, w_out, need_ctx):
    gate_x, xr_x = jnp.split(hx @ w_in, 2, axis=-1)
    if need_ctx:
        gate_c, xr_c = jnp.split(hc @ w_in, 2, axis=-1)
    else:
        xr_c = hc @ w_in[:, RNN_WIDTH:]
    xc_x = short_conv(xr_x, conv_w, conv_b)
    xc_c = short_conv(xr_c, conv_w, conv_b)
    h0 = jnp.zeros((hx.shape[0], RNN_WIDTH), jnp.float32)
    hf_c, s_f = rglru_scan(xc_c, w_a[0], b_a[0], w_x[0], b_x[0], lam[0], h0)
    hb_c, s_b = rglru_scan(jnp.flip(xc_c, 1), w_a[1], b_a[1], w_x[1], b_x[1], lam[1], h0)
    hf_x, _ = rglru_scan(xc_x, w_a[0], b_a[0], w_x[0], b_x[0], lam[0], s_f)
    hb_x, _ = rglru_scan(jnp.flip(xc_x, 1), w_a[1], b_a[1], w_x[1], b_x[1], lam[1], s_b)
    y_x = ((hf_x + jnp.flip(hb_x, 1)).astype(hx.dtype) * jax.nn.gelu(gate_x)) @ w_out
    y_c = None
    if need_ctx:
        y_c = ((hf_c + jnp.flip(hb_c, 1)).astype(hc.dtype) * jax.nn.gelu(gate_c)) @ w_out
    return y_x, y_c


def setup_inputs(seed: int = 0) -> dict:
    key = jax.random.key(seed)
    ks = iter(jax.random.split(key, 32))

    def nrm(shape, scale):
        return scale * jax.random.normal(next(ks), shape, jnp.float32)

    x = nrm((BATCH, SEQ, D_MODEL), 1.0)
    c = nrm((BATCH, D_MODEL), 1.0)
    ctx = nrm((BATCH, CTX_LEN, D_MODEL), 1.0)
    c_ctx = nrm((D_MODEL,), 1.0)
    mod_w = nrm((DEPTH, D_MODEL, N_MOD * D_MODEL), 0.5 * D_MODEL ** -0.5)
    mod_b = nrm((DEPTH, N_MOD * D_MODEL), 0.02)
    norm_g = 1.0 + nrm((DEPTH, 3, D_MODEL), 0.02)
    ffn_w_gate = nrm((DEPTH, 2, D_MODEL, D_FF), D_MODEL ** -0.5)
    ffn_w_up = nrm((DEPTH, 2, D_MODEL, D_FF), D_MODEL ** -0.5)
    ffn_w_down = nrm((DEPTH, 2, D_FF, D_MODEL), D_FF ** -0.5)
    even_w_in = nrm((N_EVEN, D_MODEL, IN_EVEN), D_MODEL ** -0.5)
    even_w_out = nrm((N_EVEN, MIX_WIDTH, D_MODEL), MIX_WIDTH ** -0.5)
    mla_cq_g = 1.0 + nrm((N_EVEN, MLA_Q_RANK), 0.02)
    mla_w_uq = nrm((N_EVEN, MLA_Q_RANK, MLA_HEADS * MLA_QK), MLA_Q_RANK ** -0.5)
    mla_ckv_g = 1.0 + nrm((N_EVEN, MLA_KV_RANK), 0.02)
    mla_w_ukv = nrm((N_EVEN, MLA_KV_RANK, MLA_HEADS * (MLA_NOPE + MLA_V)), MLA_KV_RANK ** -0.5)
    mla_q_g = 1.0 + nrm((N_EVEN, MLA_QK), 0.02)
    mla_k_g = 1.0 + nrm((N_EVEN, MLA_QK), 0.02)
    i_bias = -1.0 + nrm((N_EVEN, 2, MLSTM_HEADS), 0.1)
    f_bias = jnp.linspace(3.0, 6.0, MLSTM_HEADS, dtype=jnp.float32) + nrm((N_EVEN, 2, MLSTM_HEADS), 0.1)
    mlstm_gate_b = jnp.stack([i_bias, f_bias], axis=2).reshape(N_EVEN, 4 * MLSTM_HEADS)
    mlstm_out_g = 1.0 + nrm((N_EVEN, MLSTM_WIDTH), 0.02)
    odd_w_in = nrm((N_ODD, D_MODEL, 2 * RNN_WIDTH), D_MODEL ** -0.5)
    odd_conv_w = nrm((N_ODD, CONV_W, RNN_WIDTH), CONV_W ** -0.5)
    odd_conv_b = nrm((N_ODD, RNN_WIDTH), 0.02)
    lru_w_a = nrm((N_ODD, 2, RNN_BLOCKS, RNN_BLOCK_DIM, RNN_BLOCK_DIM), RNN_BLOCK_DIM ** -0.5)
    lru_b_a = nrm((N_ODD, 2, RNN_WIDTH), 0.02)
    lru_w_x = nrm((N_ODD, 2, RNN_BLOCKS, RNN_BLOCK_DIM, RNN_BLOCK_DIM), RNN_BLOCK_DIM ** -0.5)
    lru_b_x = nrm((N_ODD, 2, RNN_WIDTH), 0.02)
    u = jax.random.uniform(next(ks), (N_ODD, 2, RNN_WIDTH), jnp.float32, 0.9, 0.999)
    a0 = u ** (1.0 / LRU_C)
    lru_lam = jnp.log(a0) - jnp.log1p(-a0)
    odd_w_out = nrm((N_ODD, RNN_WIDTH, D_MODEL), RNN_WIDTH ** -0.5)
    return {'x': x, 'c': c, 'ctx': ctx, 'c_ctx': c_ctx,
            'mod_w': mod_w, 'mod_b': mod_b, 'norm_g': norm_g,
            'ffn_w_gate': ffn_w_gate, 'ffn_w_up': ffn_w_up, 'ffn_w_down': ffn_w_down,
            'even_w_in': even_w_in, 'even_w_out': even_w_out,
            'mla_cq_g': mla_cq_g, 'mla_w_uq': mla_w_uq, 'mla_ckv_g': mla_ckv_g, 'mla_w_ukv': mla_w_ukv,
            'mla_q_g': mla_q_g, 'mla_k_g': mla_k_g,
            'mlstm_gate_b': mlstm_gate_b, 'mlstm_out_g': mlstm_out_g,
            'odd_w_in': odd_w_in, 'odd_conv_w': odd_conv_w, 'odd_conv_b': odd_conv_b,
            'lru_w_a': lru_w_a, 'lru_b_a': lru_b_a, 'lru_w_x': lru_w_x, 'lru_b_x': lru_b_x,
            'lru_lam': lru_lam, 'odd_w_out': odd_w_out}


def reference(x, c, ctx, c_ctx, mod_w, mod_b, norm_g, ffn_w_gate, ffn_w_up, ffn_w_down,
              even_w_in, even_w_out, mla_cq_g, mla_w_uq, mla_ckv_g, mla_w_ukv, mla_q_g, mla_k_g,
              mlstm_gate_b, mlstm_out_g, odd_w_in, odd_conv_w, odd_conv_b,
              lru_w_a, lru_b_a, lru_w_x, lru_b_x, lru_lam, odd_w_out):
    n_rows = x.shape[1] // GRID_W
    cos, sin = axial_rope_tables(n_rows)
    for layer in range(DEPTH):
        need_ctx = layer < DEPTH - 1
        j = layer // 2
        mx = [m[:, None, :] for m in ada_params(c, mod_w[layer], mod_b[layer])]
        mc = ada_params(c_ctx, mod_w[layer], mod_b[layer])
        x = x + FFN_RESIDUAL * mx[2] * swiglu(modulate(rms_norm(x, norm_g[layer, 0]), mx[0], mx[1]),
                                            ffn_w_gate[layer, 0], ffn_w_up[layer, 0], ffn_w_down[layer, 0])
        ctx = ctx + FFN_RESIDUAL * mc[2] * swiglu(modulate(rms_norm(ctx, norm_g[layer, 0]), mc[0], mc[1]),
                                                ffn_w_gate[layer, 0], ffn_w_up[layer, 0], ffn_w_down[layer, 0])
        hx = modulate(rms_norm(x, norm_g[layer, 1]), mx[3], mx[4])
        hc = modulate(rms_norm(ctx, norm_g[layer, 1]), mc[3], mc[4])
        if layer % 2 == 0:
            y_x, y_c = even_mixer(hx, hc, even_w_in[j], even_w_out[j], mla_cq_g[j], mla_w_uq[j], mla_ckv_g[j],
                                  mla_w_ukv[j], mla_q_g[j], mla_k_g[j], mlstm_gate_b[j], mlstm_out_g[j],
                                  cos, sin, need_ctx)
        else:
            y_x, y_c = odd_mixer(hx, hc, odd_w_in[j], odd_conv_w[j], odd_conv_b[j], lru_w_a[j], lru_b_a[j],
                                 lru_w_x[j], lru_b_x[j], lru_lam[j], odd_w_out[j], need_ctx)
        x = x + mx[5] * y_x
        x = x + FFN_RESIDUAL * mx[8] * swiglu(modulate(rms_norm(x, norm_g[layer, 2]), mx[6], mx[7]),
                                            ffn_w_gate[layer, 1], ffn_w_up[layer, 1], ffn_w_down[layer, 1])
        if need_ctx:
            ctx = ctx + mc[5] * y_c
            ctx = ctx + FFN_RESIDUAL * mc[8] * swiglu(modulate(rms_norm(ctx, norm_g[layer, 2]), mc[6], mc[7]),
                                                    ffn_w_gate[layer, 1], ffn_w_up[layer, 1], ffn_w_down[layer, 1])
    return x
```

```cpp
#include <hip/hip_runtime.h>
#include <hip/hip_cooperative_groups.h>
#include <stdint.h>
#include <stdio.h>
namespace cg = cooperative_groups;

typedef unsigned short bf16_t;
typedef __attribute__((ext_vector_type(8))) short bf16x8;
typedef __attribute__((ext_vector_type(4))) float f32x4;

constexpr int D = 1024;
constexpr int SEQ = 8192;
constexpr int CTX = 256;
constexpr int TPB = SEQ + CTX;
constexpr int NTOK = 2 * TPB;
constexpr int DFF = 2816;
constexpr int NMOD = 9 * D;
constexpr int PW = 2816;
constexpr int NCHUNK = TPB / 64;
constexpr int NCHAIN = 16;
constexpr int NTHR = 512;
constexpr int SMEM_BYTES = 140 * 1024;

struct WDesc {
  const float* src; bf16_t* dst; const float* kscale;
  int K, N, ntn, nkt, nb, mode, item_start, pad;
};
constexpr int NWD = 22;
constexpr int N_WITEMS = 5220;

constexpr size_t al256(size_t x) { return (x + 255) & ~(size_t)255; }
constexpr size_t WGU_B = (size_t)5632 * 1024 * 2, WDN_B = (size_t)1024 * 2816 * 2, FFN_STRIDE = WGU_B + WDN_B;
constexpr size_t OFF_FFN = 0;
constexpr size_t OFF_WEIN = OFF_FFN + 4 * FFN_STRIDE;
constexpr size_t OFF_WEOUT = OFF_WEIN + al256((size_t)2816 * 1024 * 2);
constexpr size_t OFF_WUQ = OFF_WEOUT + al256((size_t)1024 * 1024 * 2);
constexpr size_t OFF_WUKV = OFF_WUQ + al256((size_t)768 * 384 * 2);
constexpr size_t OFF_WOIN = OFF_WUKV + al256((size_t)1024 * 256 * 2);
constexpr size_t OFF_WOOUT = OFF_WOIN + al256((size_t)2048 * 1024 * 2);
constexpr size_t OFF_WLRU = OFF_WOOUT + al256((size_t)1024 * 1024 * 2);
constexpr size_t WLRU_B = (size_t)2048 * 128 * 2;
constexpr size_t OFF_H = OFF_WLRU + 2 * WLRU_B;
constexpr size_t OFF_ACT = OFF_H + al256((size_t)NTOK * 1024 * 2);
constexpr size_t OFF_R = OFF_ACT + al256((size_t)NTOK * 2816 * 2);
constexpr size_t OFF_CTXRES = OFF_R + al256((size_t)NCHAIN * NCHUNK * 16384 * 2);
constexpr size_t OFF_MOD = OFF_CTXRES + al256((size_t)2 * CTX * D * 4);
constexpr size_t OFF_G = OFF_MOD + al256((size_t)2 * 3 * NMOD * 4);
constexpr size_t OFF_RS = OFF_G + al256((size_t)NTOK * 16 * 4);
constexpr size_t OFF_KR = OFF_RS + al256((size_t)NTOK * 2 * 4);
constexpr size_t OFF_DN = OFF_KR + al256((size_t)NTOK * 32 * 2);
constexpr size_t OFF_NST = OFF_DN + al256((size_t)NCHAIN * NCHUNK * 128 * 4);
constexpr size_t OFF_MLOC = OFF_NST + al256((size_t)NCHAIN * NCHUNK * 128 * 4);
constexpr size_t OFF_BEND = OFF_MLOC + al256((size_t)NCHAIN * NCHUNK * 4);
constexpr size_t OFF_MST = OFF_BEND + al256((size_t)NCHAIN * NCHUNK * 4);
constexpr size_t OFF_BAR = OFF_MST + al256((size_t)NCHAIN * NCHUNK * 4);
constexpr size_t OFF_KMAX = OFF_BAR + al256((size_t)3456 * 4);
constexpr size_t OFF_ROPE = OFF_KMAX + 256;
constexpr size_t OFF_SUMA = OFF_ROPE + 128 * 8 * 8;
constexpr size_t OFF_SUMH = OFF_SUMA + al256((size_t)8 * 264 * 256 * 4);
constexpr size_t WS_TOTAL = OFF_SUMH + al256((size_t)8 * 264 * 256 * 4);

struct Params {
  const float *x, *c, *ctx, *c_ctx, *mod_w, *mod_b, *norm_g, *ffn_w_gate, *ffn_w_up, *ffn_w_down;
  const float *even_w_in, *even_w_out, *mla_cq_g, *mla_w_uq, *mla_ckv_g, *mla_w_ukv, *mla_q_g, *mla_k_g;
  const float *mlstm_gate_b, *mlstm_out_g, *odd_w_in, *odd_conv_w, *odd_conv_b;
  const float *lru_w_a, *lru_b_a, *lru_w_x, *lru_b_x, *lru_lam, *odd_w_out;
  float* out;
  char* ws;
  __host__ __device__ __forceinline__ char* wsl() const {
#if defined(__HIP_DEVICE_COMPILE__)
    return (char*)((__attribute__((address_space(1))) char*)ws);
#else
    return ws;
#endif
  }
  __host__ __device__ __forceinline__ float* ctxres() const { return (float*)(wsl() + OFF_CTXRES); }
  __host__ __device__ __forceinline__ float* mod() const { return (float*)(wsl() + OFF_MOD); }
  __host__ __device__ __forceinline__ float* G() const { return (float*)(wsl() + OFF_G); }
  __host__ __device__ __forceinline__ float* RS() const { return (float*)(wsl() + OFF_RS); }
  __host__ __device__ __forceinline__ bf16_t* KR() const { return (bf16_t*)(wsl() + OFF_KR); }
  __host__ __device__ __forceinline__ float* dn() const { return (float*)(wsl() + OFF_DN); }
  __host__ __device__ __forceinline__ float* nst() const { return (float*)(wsl() + OFF_NST); }
  __host__ __device__ __forceinline__ float* mloc() const { return (float*)(wsl() + OFF_MLOC); }
  __host__ __device__ __forceinline__ float* bend() const { return (float*)(wsl() + OFF_BEND); }
  __host__ __device__ __forceinline__ float* mst() const { return (float*)(wsl() + OFF_MST); }
  __host__ __device__ __forceinline__ bf16_t* Wgu(int i) const { return (bf16_t*)(wsl() + OFF_FFN + (size_t)i * FFN_STRIDE); }
  __host__ __device__ __forceinline__ bf16_t* Wd(int i) const { return (bf16_t*)(wsl() + OFF_FFN + (size_t)i * FFN_STRIDE + WGU_B); }
  __host__ __device__ __forceinline__ bf16_t* Wein() const { return (bf16_t*)(wsl() + OFF_WEIN); }
  __host__ __device__ __forceinline__ bf16_t* Weout() const { return (bf16_t*)(wsl() + OFF_WEOUT); }
  __host__ __device__ __forceinline__ bf16_t* Wuq() const { return (bf16_t*)(wsl() + OFF_WUQ); }
  __host__ __device__ __forceinline__ bf16_t* Wukv() const { return (bf16_t*)(wsl() + OFF_WUKV); }
  __host__ __device__ __forceinline__ bf16_t* Woin() const { return (bf16_t*)(wsl() + OFF_WOIN); }
  __host__ __device__ __forceinline__ bf16_t* Woout() const { return (bf16_t*)(wsl() + OFF_WOOUT); }
  __host__ __device__ __forceinline__ bf16_t* Wlru(int i) const { return (bf16_t*)(wsl() + OFF_WLRU + (size_t)i * WLRU_B); }
  __host__ __device__ __forceinline__ bf16_t* H() const { return (bf16_t*)(wsl() + OFF_H); }
  __host__ __device__ __forceinline__ bf16_t* ACT() const { return (bf16_t*)(wsl() + OFF_ACT); }
  __host__ __device__ __forceinline__ bf16_t* R() const { return (bf16_t*)(wsl() + OFF_R); }
  __host__ __device__ __forceinline__ bf16_t* XC() const { return (bf16_t*)(wsl() + OFF_FFN); }
  __host__ __device__ __forceinline__ unsigned* bar() const { return (unsigned*)(wsl() + OFF_BAR); }
  __host__ __device__ __forceinline__ float* SUMA() const { return (float*)(wsl() + OFF_SUMA); }
  __host__ __device__ __forceinline__ float* SUMH() const { return (float*)(wsl() + OFF_SUMH); }
  __host__ __device__ __forceinline__ float2* ropetab() const { return (float2*)(wsl() + OFF_ROPE); }
  __host__ __device__ __forceinline__ unsigned* kmax2() const { return (unsigned*)(wsl() + OFF_KMAX); }
};

__device__ __forceinline__ float bf2f(bf16_t h) { return __uint_as_float(((uint32_t)h) << 16); }
__device__ __forceinline__ bf16_t f2bf(float f) {
  uint32_t u = __float_as_uint(f);
  u += 0x7FFFu + ((u >> 16) & 1u);
  return (bf16_t)(u >> 16);
}
__device__ __forceinline__ uint32_t pack2(float a, float b) { uint32_t r; asm("v_cvt_pk_bf16_f32 %0, %1, %2" : "=v"(r) : "v"(a), "v"(b)); return r; }
__device__ __forceinline__ float lo2f(uint32_t u) { return __uint_as_float(u << 16); }
__device__ __forceinline__ float hi2f(uint32_t u) { return __uint_as_float(u & 0xFFFF0000u); }
__device__ __forceinline__ float sigmoidf_(float x) { return __builtin_amdgcn_rcpf(1.0f + __expf(-x)); }
__device__ __forceinline__ float siluf_(float x) { return x * __builtin_amdgcn_rcpf(1.0f + __expf(-x)); }
__device__ __forceinline__ float logsigmoidf_(float x) { return fminf(x, 0.0f) - log1pf(__expf(-fabsf(x))); }
__device__ __forceinline__ float gelu_tanh(float x) {
  float z = 0.7978845608028654f * (x + 0.044715f * x * x * x);
  float t = 1.0f - 2.0f / (1.0f + __expf(2.0f * z));
  return 0.5f * x * (1.0f + t);
}
__device__ __forceinline__ float* xrow(const Params& p, int r) {
  int b = r >= TPB ? 1 : 0; int u = r - b * TPB;
  return (u < CTX) ? p.ctxres() + (size_t)(b * CTX + u) * D : p.out + ((size_t)b * SEQ + (u - CTX)) * D;
}
__device__ __forceinline__ int condof(int r) { int b = r >= TPB ? 1 : 0; int u = r - b * TPB; return u < CTX ? 2 : b; }
__device__ __forceinline__ float wave_sum(float v) {
#pragma unroll
  for (int o = 32; o >= 1; o >>= 1) v += __shfl_xor(v, o);
  return v;
}
__device__ __forceinline__ float wave_max(float v) {
#pragma unroll
  for (int o = 32; o >= 1; o >>= 1) v = fmaxf(v, __shfl_xor(v, o));
  return v;
}
__device__ __forceinline__ int otid() { int t = threadIdx.x; asm volatile("" : "+v"(t)); return t; }
__device__ __forceinline__ int obid() { int t = blockIdx.x; asm volatile("" : "+s"(t)); return t; }
__device__ const float ROPE_INV[8] = {1.0f, 0.316227766016838f, 0.1f, 0.0316227766016838f, 0.01f, 0.00316227766016838f, 0.001f, 0.000316227766016838f};
#define MFMA16(a, b, c) __builtin_amdgcn_mfma_f32_16x16x32_bf16(a, b, c, 0, 0, 0)


__device__ __forceinline__ WDesc get_wdesc(const Params& p, int wi) {
  WDesc d; d.kscale = nullptr; d.nb = 1; d.pad = 0;
  if (wi < 4224) {
    int di = wi / 352, lf = di / 3, kind = di - lf * 3;
    d.item_start = di * 352;
    if (kind == 0) { d.src = p.ffn_w_gate + (size_t)lf * 1024 * 2816; d.dst = p.Wgu(lf); d.K = 1024; d.N = 2816; d.ntn = 44; d.nkt = 8; d.mode = 1; }
    else if (kind == 1) { d.src = p.ffn_w_up + (size_t)lf * 1024 * 2816; d.dst = p.Wgu(lf); d.K = 1024; d.N = 2816; d.ntn = 44; d.nkt = 8; d.mode = 2; }
    else { d.src = p.ffn_w_down + (size_t)lf * 2816 * 1024; d.dst = p.Wd(lf); d.K = 2816; d.N = 1024; d.ntn = 16; d.nkt = 22; d.mode = 0; }
  } else if (wi < 4576) { d.src = p.even_w_in; d.dst = p.Wein(); d.K = 1024; d.N = 2736; d.ntn = 44; d.nkt = 8; d.mode = 0; d.item_start = 4224; }
  else if (wi < 4704) { d.src = p.even_w_out; d.dst = p.Weout(); d.K = 1024; d.N = 1024; d.ntn = 16; d.nkt = 8; d.mode = 0; d.item_start = 4576; }
  else if (wi < 4740) { d.src = p.mla_w_uq; d.dst = p.Wuq(); d.kscale = p.mla_cq_g; d.K = 384; d.N = 768; d.ntn = 12; d.nkt = 3; d.mode = 0; d.item_start = 4704; }
  else if (wi < 4772) { d.src = p.mla_w_ukv; d.dst = p.Wukv(); d.kscale = p.mla_ckv_g; d.K = 256; d.N = 1024; d.ntn = 16; d.nkt = 2; d.mode = 0; d.item_start = 4740; }
  else if (wi < 5028) { d.src = p.odd_w_in; d.dst = p.Woin(); d.K = 1024; d.N = 2048; d.ntn = 32; d.nkt = 8; d.mode = 0; d.item_start = 4772; }
  else if (wi < 5156) { d.src = p.odd_w_out; d.dst = p.Woout(); d.K = 1024; d.N = 1024; d.ntn = 16; d.nkt = 8; d.mode = 0; d.item_start = 5028; }
  else {
    int q = (wi - 5156) >> 4, dir = q >> 1, gx = q & 1;
    d.src = (gx ? p.lru_w_x : p.lru_w_a) + (size_t)dir * 8 * 128 * 128; d.dst = p.Wlru(dir);
    d.K = 128; d.N = 128; d.ntn = 2; d.nkt = 1; d.nb = 8; d.mode = 1 + gx; d.item_start = 5156 + q * 16;
  }
  return d;
}

__device__ __forceinline__ void wload(const WDesc& d, int wi, int tid, float4 (&v)[4]) {
  int local = wi - d.item_start;
  int tiles = d.ntn * d.nkt;
  int bi = local / tiles, rem = local - bi * tiles;
  int kt = rem / d.ntn, nt = rem - kt * d.ntn;
  const float* src = d.src + (size_t)bi * d.K * d.N;
  int k0 = kt * 128, n0 = nt * 64;
#pragma unroll
  for (int i = 0; i < 4; ++i) {
    int idx = tid + i * NTHR;
    int k = idx >> 4, n4 = (idx & 15) * 4;
    v[i] = make_float4(0, 0, 0, 0);
    if (n0 + n4 < d.N) v[i] = *(const float4*)(src + (size_t)(k0 + k) * d.N + n0 + n4);
    if (d.kscale) { float g = d.kscale[k0 + k]; v[i].x *= g; v[i].y *= g; v[i].z *= g; v[i].w *= g; }
  }
}
__device__ __forceinline__ int wsw(int n, int k) { return n * 136 + ((((k >> 3) ^ (n >> 2)) & 15) << 3) + (k & 7); }
__device__ __forceinline__ void wstore(const WDesc& d, int wi, int tid, const float4 (&v)[4], bf16_t* s) {
  int local = wi - d.item_start;
  int tiles = d.ntn * d.nkt;
  int bi = local / tiles, rem = local - bi * tiles;
  int kt = rem / d.ntn, nt = rem - kt * d.ntn;
  int k0 = kt * 128, n0 = nt * 64;
#pragma unroll
  for (int i = 0; i < 4; ++i) {
    int idx = tid + i * NTHR;
    int k = idx >> 4, n4 = (idx & 15) * 4;
    s[wsw(n4 + 0, k)] = f2bf(v[i].x);
    s[wsw(n4 + 1, k)] = f2bf(v[i].y);
    s[wsw(n4 + 2, k)] = f2bf(v[i].z);
    s[wsw(n4 + 3, k)] = f2bf(v[i].w);
  }
  __syncthreads();
#pragma unroll
  for (int i = 0; i < 2; ++i) {
    int idx = tid + i * NTHR;
    int n = idx >> 4, kc = (idx & 15) * 8;
    int gidx = bi * d.N + n0 + n;
    int drow = gidx;
    if (d.mode != 0) drow = (gidx >> 6) * 128 + ((gidx & 63) >> 4) * 32 + (gidx & 15) + (d.mode == 2 ? 16 : 0);
    uint4 o = *(const uint4*)(s + wsw(n, kc));
    *(uint4*)(d.dst + (size_t)drow * d.K + k0 + kc) = o;
  }
  __syncthreads();
}

__device__ __forceinline__ void p0_phase(const Params& p, char* smem) {
  const int tid = otid();
  const int G = gridDim.x, bid = obid();
  for (int it = bid; it < 144; it += G) {
    int layer = it / 72, cgp = it % 72;
    float* sc = (float*)smem;
    float* red = sc + 3 * 1024;
    for (int i = tid; i < 3 * 1024; i += NTHR) {
      int r = i >> 10, k = i & 1023;
      float v = (r < 2) ? p.c[r * 1024 + k] : p.c_ctx[k];
      sc[i] = siluf_(v);
    }
    __syncthreads();
    int ksl = tid >> 5, l32 = tid & 31;
    int col = cgp * 128 + l32 * 4;
    float a0[4] = {0, 0, 0, 0}, a1[4] = {0, 0, 0, 0}, a2[4] = {0, 0, 0, 0};
    const float* wp = p.mod_w + ((size_t)layer * 1024 + ksl * 64) * NMOD + col;
#pragma unroll 16
    for (int k = 0; k < 64; ++k) {
      float4 wv = *(const float4*)(wp + (size_t)k * NMOD);
      float s0 = sc[ksl * 64 + k], s1 = sc[1024 + ksl * 64 + k], s2 = sc[2048 + ksl * 64 + k];
      a0[0] += s0 * wv.x; a0[1] += s0 * wv.y; a0[2] += s0 * wv.z; a0[3] += s0 * wv.w;
      a1[0] += s1 * wv.x; a1[1] += s1 * wv.y; a1[2] += s1 * wv.z; a1[3] += s1 * wv.w;
      a2[0] += s2 * wv.x; a2[1] += s2 * wv.y; a2[2] += s2 * wv.z; a2[3] += s2 * wv.w;
    }
#pragma unroll
    for (int q = 0; q < 4; ++q) {
      red[(ksl * 3 + 0) * 128 + l32 * 4 + q] = a0[q];
      red[(ksl * 3 + 1) * 128 + l32 * 4 + q] = a1[q];
      red[(ksl * 3 + 2) * 128 + l32 * 4 + q] = a2[q];
    }
    __syncthreads();
    if (tid < 384) {
      int r = tid >> 7, cc = tid & 127;
      float sum = 0;
#pragma unroll
      for (int ww = 0; ww < 16; ++ww) sum += red[(ww * 3 + r) * 128 + cc];
      int gc = cgp * 128 + cc;
      p.mod()[((size_t)layer * 3 + r) * NMOD + gc] = sum + p.mod_b[layer * NMOD + gc];
    }
    __syncthreads();
  }
  {
    bf16_t* s = (bf16_t*)smem;
    int wi = (bid + G - (144 % G)) % G;
    float4 v[4], vn[4];
    WDesc d = get_wdesc(p, wi < N_WITEMS ? wi : 0);
    if (wi < N_WITEMS) wload(d, wi, tid, v);
    while (wi < N_WITEMS) {
      int win = wi + G;
      WDesc dn = get_wdesc(p, win < N_WITEMS ? win : 0);
      if (win < N_WITEMS) wload(dn, win, tid, vn);
      wstore(d, wi, tid, v, s);
#pragma unroll
      for (int i = 0; i < 4; ++i) v[i] = vn[i];
      d = dn; wi = win;
    }
  }
  for (int i = bid * NTHR + tid; i < 1024; i += G * NTHR) {
    float ang = (float)(i >> 3) * ROPE_INV[i & 7];
    p.ropetab()[i] = make_float2(cosf(ang), sinf(ang));
  }
  for (int i = bid * NTHR + tid; i < 2 * CTX * D / 4; i += G * NTHR) ((float4*)p.ctxres())[i] = ((const float4*)p.ctx)[i];
}

__device__ __forceinline__ void normmod_phase(const Params& p, int layer, int which, int first) {
  const int tid_ = otid();
  const int lane = tid_ & 63, w = tid_ >> 6;
  const float* g = p.norm_g + (layer * 3 + which) * D;
  const int stride = gridDim.x * 8;
  const float* xlat = first ? p.x : p.out;
  for (int row0 = obid() * 8 + w; row0 < NTOK; row0 += 2 * stride) {
    float4 v[2][4];
    bool ok[2];
#pragma unroll
    for (int q = 0; q < 2; ++q) {
      int row = row0 + q * stride;
      ok[q] = row < NTOK;
      if (ok[q]) {
        int b = row >= TPB ? 1 : 0, u = row - b * TPB;
        const float* x = (u < CTX) ? p.ctxres() + (size_t)(b * CTX + u) * D : xlat + ((size_t)b * SEQ + (u - CTX)) * D;
#pragma unroll
        for (int i = 0; i < 4; ++i) v[q][i] = *(const float4*)(x + i * 256 + lane * 4);
      }
    }
#pragma unroll
    for (int q = 0; q < 2; ++q) {
      if (!ok[q]) continue;
      int row = row0 + q * stride;
      const float* md = p.mod() + ((size_t)layer * 3 + condof(row)) * NMOD + which * 3 * D;
      float ss = 0;
#pragma unroll
      for (int i = 0; i < 4; ++i) ss += v[q][i].x * v[q][i].x + v[q][i].y * v[q][i].y + v[q][i].z * v[q][i].z + v[q][i].w * v[q][i].w;
      ss = wave_sum(ss);
      float rstd = rsqrtf(ss * (1.0f / D) + 1e-6f);
#pragma unroll
      for (int i = 0; i < 4; ++i) {
        int cidx = i * 256 + lane * 4;
        float4 g4 = *(const float4*)(g + cidx);
        float4 sh = *(const float4*)(md + cidx);
        float4 sc = *(const float4*)(md + D + cidx);
        float h0 = v[q][i].x * rstd * g4.x * (1.0f + sc.x) + sh.x;
        float h1 = v[q][i].y * rstd * g4.y * (1.0f + sc.y) + sh.y;
        float h2 = v[q][i].z * rstd * g4.z * (1.0f + sc.z) + sh.z;
        float h3 = v[q][i].w * rstd * g4.w * (1.0f + sc.w) + sh.w;
        uint2 o; o.x = pack2(h0, h1); o.y = pack2(h2, h3);
        *(uint2*)(p.H() + (size_t)row * D + cidx) = o;
      }
    }
  }
}

enum { EPI_SWIGLU = 1, EPI_RESID = 2, EPI_E1 = 3, EPI_ROWSCALE = 4, EPI_PLAIN = 5, EPI_LRU = 6 };
struct EpiArgs {
  bf16_t* outb; int ldo; int slot; float scale; int layer; int dir;
  float* outf; const float* rs; uint32_t* outu;
};
constexpr int LDT = 72;

template <int EPI>
__device__ __forceinline__ void gemm_tile(const Params& p, const EpiArgs& ea, const bf16_t* __restrict__ A, int lda,
                                          const bf16_t* __restrict__ Bt, int K, int m0, int n0, char* smem) {
  bf16_t* sA = (bf16_t*)smem;
  bf16_t* sB = sA + 2 * 256 * LDT;
  const int tid = otid(), lane = tid & 63, w = tid >> 6, wm = w & 3, wn = w >> 2, fr = lane & 15, fq = lane >> 4;
  f32x4 acc[4][4];
#pragma unroll
  for (int i = 0; i < 4; ++i)
#pragma unroll
    for (int j = 0; j < 4; ++j) acc[i][j] = (f32x4){0.f, 0.f, 0.f, 0.f};
  const int srow = tid >> 3, sch = (tid & 7) * 8;
  const bf16_t* ap = A + (size_t)(m0 + srow) * lda + sch;
  const bf16_t* bp = Bt + (size_t)(n0 + srow) * K + sch;
  const size_t a_step = (size_t)64 * lda, b_step = (size_t)64 * K;
  uint4 ra[4], rb[2];
  const int nk = K >> 6;
#pragma unroll
  for (int i = 0; i < 4; ++i) ra[i] = *(const uint4*)(ap + i * a_step);
#pragma unroll
  for (int i = 0; i < 2; ++i) rb[i] = *(const uint4*)(bp + i * b_step);
#pragma unroll
  for (int i = 0; i < 4; ++i) *(uint4*)(sA + (srow + i * 64) * LDT + sch) = ra[i];
#pragma unroll
  for (int i = 0; i < 2; ++i) *(uint4*)(sB + (srow + i * 64) * LDT + sch) = rb[i];
  __syncthreads();
  for (int kt = 0; kt < nk; ++kt) {
    const int buf = kt & 1;
    if (kt + 1 < nk) {
#pragma unroll
      for (int i = 0; i < 4; ++i) ra[i] = *(const uint4*)(ap + i * a_step + (kt + 1) * 64);
#pragma unroll
      for (int i = 0; i < 2; ++i) rb[i] = *(const uint4*)(bp + i * b_step + (kt + 1) * 64);
    }
    const bf16_t* cA = sA + buf * 256 * LDT + (wm * 64 + fr) * LDT + fq * 8;
    const bf16_t* cB = sB + buf * 128 * LDT + (wn * 64 + fr) * LDT + fq * 8;
#pragma unroll
    for (int ks = 0; ks < 2; ++ks) {
      bf16x8 af[4], bfg[4];
#pragma unroll
      for (int mi = 0; mi < 4; ++mi) af[mi] = *(const bf16x8*)(cA + mi * 16 * LDT + ks * 32);
#pragma unroll
      for (int ni = 0; ni < 4; ++ni) bfg[ni] = *(const bf16x8*)(cB + ni * 16 * LDT + ks * 32);
#pragma unroll
      for (int mi = 0; mi < 4; ++mi)
#pragma unroll
        for (int ni = 0; ni < 4; ++ni) acc[mi][ni] = MFMA16(af[mi], bfg[ni], acc[mi][ni]);
    }
    if (kt + 1 < nk) {
      bf16_t* dA = sA + (buf ^ 1) * 256 * LDT;
      bf16_t* dB = sB + (buf ^ 1) * 128 * LDT;
#pragma unroll
      for (int i = 0; i < 4; ++i) *(uint4*)(dA + (srow + i * 64) * LDT + sch) = ra[i];
#pragma unroll
      for (int i = 0; i < 2; ++i) *(uint4*)(dB + (srow + i * 64) * LDT + sch) = rb[i];
    }
    __syncthreads();
  }
#pragma unroll
  for (int mi = 0; mi < 4; ++mi) {
    const int r0 = m0 + wm * 64 + mi * 16 + fq * 4;
    if (EPI == EPI_SWIGLU) {
#pragma unroll
      for (int nh = 0; nh < 2; ++nh) {
        int hc = (n0 >> 1) + wn * 32 + nh * 16 + fr;
#pragma unroll
        for (int j = 0; j < 4; ++j) {
          float g = acc[mi][nh * 2][j], u = acc[mi][nh * 2 + 1][j];
          ea.outb[(size_t)(r0 + j) * ea.ldo + hc] = f2bf(siluf_(g) * u);
        }
      }
    } else if (EPI == EPI_RESID) {
      float* xb = xrow(p, r0);
      const float* md = p.mod() + ((size_t)ea.layer * 3 + condof(r0)) * NMOD + ea.slot * D;
#pragma unroll
      for (int ni = 0; ni < 4; ++ni) {
        int cc = n0 + wn * 64 + ni * 16 + fr;
        float gs = md[cc] * ea.scale;
#pragma unroll
        for (int j = 0; j < 4; ++j) {
          float* px = xb + (size_t)j * D + cc;
          *px = *px + gs * acc[mi][ni][j];
        }
      }
    } else if (EPI == EPI_E1) {
#pragma unroll
      for (int ni = 0; ni < 4; ++ni) {
        int cc = n0 + wn * 64 + ni * 16 + fr;
        float sc = (cc >= 1184 && cc < 1696) ? 0.08838834764831845f : 1.0f;
#pragma unroll
        for (int j = 0; j < 4; ++j) {
          float v = acc[mi][ni][j];
          ea.outb[(size_t)(r0 + j) * PW + cc] = f2bf(v * sc);
          if (cc >= 2720 && cc < 2736) ea.outf[(size_t)(r0 + j) * 16 + (cc - 2720)] = v;
        }
      }
    } else if (EPI == EPI_ROWSCALE) {
#pragma unroll
      for (int j = 0; j < 4; ++j) {
        float rs = ea.rs[(size_t)(r0 + j) * 2];
#pragma unroll
        for (int ni = 0; ni < 4; ++ni) {
          int cc = n0 + wn * 64 + ni * 16 + fr;
          ea.outb[(size_t)(r0 + j) * ea.ldo + cc] = f2bf(acc[mi][ni][j] * rs);
        }
      }
    } else if (EPI == EPI_PLAIN) {
#pragma unroll
      for (int ni = 0; ni < 4; ++ni) {
        int cc = n0 + wn * 64 + ni * 16 + fr;
#pragma unroll
        for (int j = 0; j < 4; ++j) ea.outb[(size_t)(r0 + j) * ea.ldo + cc] = f2bf(acc[mi][ni][j]);
      }
    } else if (EPI == EPI_LRU) {
#pragma unroll
      for (int nh = 0; nh < 2; ++nh) {
        int ch = (n0 >> 1) + wn * 32 + nh * 16 + fr;
        float ba = p.lru_b_a[ea.dir * 1024 + ch], bx = p.lru_b_x[ea.dir * 1024 + ch];
        float sp8 = -8.0f * log1pf(__expf(-p.lru_lam[ea.dir * 1024 + ch]));
#pragma unroll
        for (int j = 0; j < 4; ++j) {
          float r = sigmoidf_(acc[mi][nh * 2][j] + ba);
          float ig = sigmoidf_(acc[mi][nh * 2 + 1][j] + bx);
          float la = r * sp8;
          float x2 = 2.0f * la;
          float poly = -x2 * (1.0f + x2 * (0.5f + x2 * (0.16666667f + x2 * (0.041666668f + x2 * (0.008333334f + x2 * 0.0013888889f)))));
          float em = (x2 < -0.3f) ? (1.0f - __expf(x2)) : poly;
          float u = bf2f(p.XC()[(size_t)(r0 + j) * D + ch]);
          float inp = __builtin_amdgcn_sqrtf(fmaxf(em, 0.0f)) * (ig * u);
          ea.outu[(size_t)(r0 + j) * D + ch] = pack2(la, inp);
        }
      }
    }
  }
}

namespace pg8 {
#define PG8_LAS __attribute__((address_space(3)))
typedef unsigned u32x4 __attribute__((ext_vector_type(4)));
constexpr int BM = 256, BK = 64, HALF = 128, HTB = HALF * BK * 2, STAGE_BYTES = 8 * HTB, NXCD = 8, WGM = 8;
__device__ __forceinline__ int lds_byte(int r, int c) { const int st = (r >> 4) * 2 + (c >> 5), rr = r & 15, cc = c & 31, ob = rr * 64 + cc * 2; return st * 1024 + (ob ^ (((ob >> 9) & 1) << 5)); }
__device__ __forceinline__ void stage_rc(int b, int& R, int& C) { const int st = b / 1024, sb = b % 1024, swz = sb ^ (((sb >> 9) & 1) << 5); R = (st >> 1) * 16 + swz / 64; C = (st & 1) * 32 + (swz % 64) / 2; }
struct Unit { int pm, pn; };
struct Gemm { const bf16_t* A; int lda; const bf16_t* Bt; int K; };
struct Sched {
  int nM, nN, nwg, G, c, latent;
  __device__ void init(int nM_, int nN_, int G_, int c_, int latent_) { nM = nM_; nN = nN_; nwg = nM * nN; G = G_; c = c_; latent = latent_; }
  __device__ bool next(int i, Unit& u) const {
    const long L = (long)i * G + c; if (L >= nwg) return false;
    int wgid = (int)L; { const int q = nwg / NXCD, r = nwg % NXCD, xcd = wgid % NXCD, off = wgid / NXCD; wgid = (xcd < r ? xcd * (q + 1) : r * (q + 1) + (xcd - r) * q) + off; }
    const int nig = WGM * nN, gid = wgid / nig, fm = gid * WGM, gsz = (nM - fm) < WGM ? (nM - fm) : WGM;
    int pm = fm + ((wgid % nig) % gsz); u.pn = (wgid % nig) / gsz;
    if (latent) pm = pm + 1 + (pm >= 32 ? 1 : 0);
    u.pm = pm; return true;
  }
};
template <class Epi>
__device__ __forceinline__ void gemm_phase(PG8_LAS unsigned char* lds, const Gemm g, const Sched& S, const Epi& E) {
    const int tid = otid(), wid = __builtin_amdgcn_readfirstlane(tid >> 6), lane = tid & 63, wr = wid >> 2, wc = wid & 3, fr = lane & 15, fq = lane >> 4;
    const int K = g.K, nt = K / BK, lda = g.lda;
    unsigned voffA[2], voffB[2];
#pragma unroll
    for (int i = 0; i < 2; ++i) { int R, C; stage_rc(tid * 16 + i * 8192, R, C);
        voffA[i] = (unsigned)(R * lda + C) * 2u; voffB[i] = (unsigned)(R * K + C) * 2u; }
    const size_t kstep = (size_t)(BK * 2);
    const size_t hsA = (size_t)HALF * lda * 2, hsB = (size_t)HALF * K * 2;
    const size_t tsA = 2 * hsA, tsB = 2 * hsB;
    const unsigned ldsw = (unsigned)wid * 1024u;
    const int aoff = lds_byte(wr * 64 + fr, fq * 8), boff = lds_byte(wc * 32 + fr, fq * 8);
#define PG8_SA(b, h) (((b) * 2 + (h)) * HTB)
#define PG8_SB(b, h) ((4 + (b) * 2 + (h)) * HTB)
#define PG8_STAGE(bufoff, gbase, voff) do { _Pragma("unroll") for (int _i = 0; _i < 2; ++_i) \
        __builtin_amdgcn_global_load_lds((const unsigned*)((const char*)(gbase) + (voff)[_i]), (PG8_LAS unsigned*)(lds + (bufoff) + ldsw + _i * 8192), 16, 0, 0); } while (0)
#define PG8_LDA(dst, b, h) do { _Pragma("unroll") for (int m = 0; m < 4; ++m) _Pragma("unroll") for (int k = 0; k < 2; ++k) dst[m][k] = *(const PG8_LAS bf16x8*)(lds + PG8_SA(b, h) + aoff + m * 2048 + k * 1024); } while (0)
#define PG8_LDB(dst, b, h) do { _Pragma("unroll") for (int n = 0; n < 2; ++n) _Pragma("unroll") for (int k = 0; k < 2; ++k) dst[n][k] = *(const PG8_LAS bf16x8*)(lds + PG8_SB(b, h) + boff + n * 2048 + k * 1024); } while (0)
#define PG8_MMA(ai, bj, At, Bt) do { __builtin_amdgcn_s_setprio(1); _Pragma("unroll") for (int m = 0; m < 4; ++m) _Pragma("unroll") for (int n = 0; n < 2; ++n) _Pragma("unroll") for (int k = 0; k < 2; ++k) \
        acc[ai][bj][m][n] = __builtin_amdgcn_mfma_f32_16x16x32_bf16(Bt[n][k], At[m][k], acc[ai][bj][m][n], 0, 0, 0); __builtin_amdgcn_s_setprio(0); } while (0)
#define PG8_WAIT_V(n) asm volatile("s_waitcnt vmcnt(" #n ")" ::: "memory")
#define PG8_WAIT_L(n) asm volatile("s_waitcnt lgkmcnt(" #n ")" ::: "memory")
#define PG8_BAR __builtin_amdgcn_s_barrier()
#define PG8_SCHED __builtin_amdgcn_sched_barrier(0)
    Unit cur, nxt; int ui = 0;
    if (!S.next(0, cur)) return;
    f32x4 acc[2][2][4][2];
#pragma unroll
    for (int a = 0; a < 2; ++a)
#pragma unroll
        for (int b = 0; b < 2; ++b)
#pragma unroll
            for (int m = 0; m < 4; ++m)
#pragma unroll
                for (int n = 0; n < 2; ++n) acc[a][b][m][n] = (f32x4){0.f, 0.f, 0.f, 0.f};
    bf16x8 At[4][2], B0[2][2], B1[2][2];
    const char* cA = (const char*)g.A + (size_t)cur.pm * tsA; const char* cB = (const char*)g.Bt + (size_t)cur.pn * tsB;
    PG8_STAGE(PG8_SB(0, 0), cB, voffB); PG8_STAGE(PG8_SA(0, 0), cA, voffA); PG8_STAGE(PG8_SB(0, 1), cB + hsB, voffB); PG8_STAGE(PG8_SA(0, 1), cA + hsA, voffA);
    if (wr == 1) PG8_BAR;
    PG8_WAIT_V(4); PG8_BAR;
    PG8_STAGE(PG8_SB(1, 0), cB + kstep, voffB); PG8_STAGE(PG8_SA(1, 0), cA + kstep, voffA); PG8_STAGE(PG8_SB(1, 1), cB + hsB + kstep, voffB);
    PG8_WAIT_V(6); PG8_BAR;
    for (;;) {
        const bool has_next = S.next(ui + 1, nxt);
        const char* nA = has_next ? (const char*)g.A + (size_t)nxt.pm * tsA : cA; const char* nB = has_next ? (const char*)g.Bt + (size_t)nxt.pn * tsB : cB;
        for (int t = 0; t < nt; t += 2) {
            const bool last = (t == nt - 2);
            const char* a1 = cA + (size_t)(t + 1) * kstep;
            const char* a2 = last ? nA : cA + (size_t)(t + 2) * kstep; const char* b2 = last ? nB : cB + (size_t)(t + 2) * kstep;
            const char* a3 = a2 + kstep; const char* b3 = b2 + kstep;
            PG8_LDB(B0, 0, 0); PG8_SCHED; PG8_LDA(At, 0, 0); PG8_STAGE(PG8_SA(1, 1), a1 + hsA, voffA);
            PG8_WAIT_L(8); PG8_BAR; PG8_WAIT_L(0); PG8_MMA(0, 0, At, B0); PG8_BAR; PG8_SCHED;
            PG8_LDB(B1, 0, 1); PG8_STAGE(PG8_SB(0, 0), b2, voffB);
            PG8_BAR; PG8_WAIT_L(0); PG8_MMA(0, 1, At, B1); PG8_BAR;
            PG8_LDA(At, 0, 1); PG8_STAGE(PG8_SA(0, 0), a2, voffA);
            PG8_BAR; PG8_WAIT_L(0); PG8_MMA(1, 0, At, B0); PG8_BAR; PG8_SCHED;
            PG8_STAGE(PG8_SB(0, 1), b2 + hsB, voffB);
            PG8_WAIT_V(6); PG8_BAR; PG8_MMA(1, 1, At, B1); PG8_BAR;
            PG8_LDB(B0, 1, 0); PG8_SCHED; PG8_LDA(At, 1, 0); PG8_STAGE(PG8_SA(0, 1), a2 + hsA, voffA);
            PG8_WAIT_L(8); PG8_BAR; PG8_WAIT_L(0); PG8_MMA(0, 0, At, B0); PG8_BAR; PG8_SCHED;
            PG8_LDB(B1, 1, 1); PG8_STAGE(PG8_SB(1, 0), b3, voffB);
            PG8_BAR; PG8_WAIT_L(0); PG8_MMA(0, 1, At, B1); PG8_BAR;
            PG8_LDA(At, 1, 1); PG8_STAGE(PG8_SA(1, 0), a3, voffA);
            PG8_BAR; PG8_WAIT_L(0); PG8_MMA(1, 0, At, B0); PG8_BAR; PG8_SCHED;
            PG8_STAGE(PG8_SB(1, 1), b3 + hsB, voffB);
            PG8_WAIT_V(6); PG8_BAR; PG8_MMA(1, 1, At, B1); PG8_BAR;
        }
        E(acc, cur, wr, wc, fr, fq);
        if (!has_next) break;
#pragma unroll
        for (int a = 0; a < 2; ++a)
#pragma unroll
            for (int b = 0; b < 2; ++b)
#pragma unroll
                for (int m = 0; m < 4; ++m)
#pragma unroll
                    for (int n = 0; n < 2; ++n) acc[a][b][m][n] = (f32x4){0.f, 0.f, 0.f, 0.f};
        cur = nxt; cA = nA; cB = nB; ++ui;
    }
    PG8_WAIT_V(0);
    if (wr == 0) PG8_BAR;
    PG8_BAR;
#undef PG8_SA
#undef PG8_SB
#undef PG8_STAGE
#undef PG8_LDA
#undef PG8_LDB
#undef PG8_MMA
#undef PG8_WAIT_V
#undef PG8_WAIT_L
#undef PG8_BAR
#undef PG8_SCHED
}
}

struct FEpi {
  int kind; float* xout; float* xctx; const float* xin; const float* modp; bf16_t* outb; int ldo; int slot; float scale; int layer; float* outf; const float* rs;
  __device__ __forceinline__ void operator()(const f32x4 (&acc)[2][2][4][2], const pg8::Unit& u, int wr, int wc, int fr, int fq) const {
#pragma unroll
    for (int ai = 0; ai < 2; ++ai)
#pragma unroll
      for (int m = 0; m < 4; ++m) {
        const int row = u.pm * 256 + ai * 128 + wr * 64 + m * 16 + fr;
        if (kind == EPI_SWIGLU) {
#pragma unroll
          for (int bj = 0; bj < 2; ++bj) {
            int hc = u.pn * 128 + bj * 64 + wc * 16 + fq * 4;
            f32x4 g = acc[ai][bj][m][0], up = acc[ai][bj][m][1];
            uint2 o; o.x = pack2(siluf_(g[0]) * up[0], siluf_(g[1]) * up[1]); o.y = pack2(siluf_(g[2]) * up[2], siluf_(g[3]) * up[3]);
            *(uint2*)(outb + (size_t)row * ldo + hc) = o;
          }
        } else if (kind == EPI_RESID) {
          float* xb;
          { int b_ = row >= TPB ? 1 : 0; int u_ = row - b_ * TPB;
            xb = (u_ < CTX) ? xctx + (size_t)(b_ * CTX + u_) * D : xout + ((size_t)b_ * SEQ + (u_ - CTX)) * D; }
          const float* xr = (xb >= xout && xb < xout + (size_t)2 * SEQ * D) ? xin + (xb - xout) : xb;
          const float* md = modp + ((size_t)layer * 3 + condof(row)) * NMOD + slot * D;
#pragma unroll
          for (int bj = 0; bj < 2; ++bj)
#pragma unroll
            for (int n = 0; n < 2; ++n) {
              int cc = u.pn * 256 + bj * 128 + wc * 32 + n * 16 + fq * 4;
              float4 gs = *(const float4*)(md + cc);
              float4 xv = *(const float4*)(xr + cc);
              f32x4 a = acc[ai][bj][m][n];
              xv.x += scale * gs.x * a[0]; xv.y += scale * gs.y * a[1]; xv.z += scale * gs.z * a[2]; xv.w += scale * gs.w * a[3];
              *(float4*)(xb + cc) = xv;
            }
        } else if (kind == EPI_E1) {
#pragma unroll
          for (int bj = 0; bj < 2; ++bj)
#pragma unroll
            for (int n = 0; n < 2; ++n) {
              int cc = u.pn * 256 + bj * 128 + wc * 32 + n * 16 + fq * 4;
              float sc = (cc >= 1184 && cc < 1696) ? 0.08838834764831845f : 1.0f;
              f32x4 a = acc[ai][bj][m][n];
              uint2 o; o.x = pack2(a[0] * sc, a[1] * sc); o.y = pack2(a[2] * sc, a[3] * sc);
              *(uint2*)(outb + (size_t)row * PW + cc) = o;
              if (cc >= 2720 && cc < 2736) *(float4*)(outf + (size_t)row * 16 + (cc - 2720)) = make_float4(a[0], a[1], a[2], a[3]);
            }
        } else {
          float rsv = (kind == EPI_ROWSCALE) ? rs[(size_t)row * 2] : 1.0f;
#pragma unroll
          for (int bj = 0; bj < 2; ++bj)
#pragma unroll
            for (int n = 0; n < 2; ++n) {
              int cc = u.pn * 256 + bj * 128 + wc * 32 + n * 16 + fq * 4;
              f32x4 a = acc[ai][bj][m][n];
              uint2 o; o.x = pack2(a[0] * rsv, a[1] * rsv); o.y = pack2(a[2] * rsv, a[3] * rsv);
              *(uint2*)(outb + (size_t)row * ldo + cc) = o;
            }
        }
      }
  }
};

template <int KIND>
struct FEpiK : FEpi {
  __device__ __forceinline__ void operator()(const f32x4 (&acc)[2][2][4][2], const pg8::Unit& u, int wr, int wc, int fr, int fq) const {
    FEpi e = *this; e.kind = KIND; e(acc, u, wr, wc, fr, fq);
  }
};

template <int KIND>
__device__ __forceinline__ void fast_gemm(const Params& p, FEpi e, const bf16_t* A, int lda, const bf16_t* Bt, int K, int nN, int latent, char* smem) {
  pg8::Sched S; S.init(latent ? 64 : 66, nN, gridDim.x, obid(), latent);
  pg8::Gemm g{A, lda, Bt, K};
  FEpiK<KIND> ek; *(FEpi*)&ek = e; ek.xout = p.out; ek.xctx = p.ctxres(); ek.modp = p.mod(); ek.xin = e.xin ? e.xin : p.out;
  pg8::gemm_phase(( __attribute__((address_space(3))) unsigned char*)smem, g, S, ek);
}

template <int KIND>
__device__ __forceinline__ void ctx_gemm(const Params& p, const FEpi& e, const bf16_t* A, int lda, const bf16_t* Bt, int K, int col0, int ncg, char* smem) {
  const int tid = otid(), lane = tid & 63, w = tid >> 6, fr = lane & 15, fq = lane >> 4;
  bf16_t* sA = (bf16_t*)smem;
  bf16_t* sB = sA + 2 * 32 * 136;
  const int mr = w & 1, nc = w >> 1;
  for (int it = obid(); it < 16 * ncg; it += gridDim.x) {
    const int rg = it & 15, cgp = it >> 4;
    const int cr0 = rg * 32;
    const int rowb = (cr0 >> 8) * TPB + (cr0 & 255);
    const int cb = col0 + cgp * 64;
    const int r0 = tid >> 4, ch = (tid & 15) * 8;
    const bf16_t* g0 = A + (size_t)(rowb + r0) * lda + ch;
    const bf16_t* g1 = Bt + (size_t)(cb + r0) * K + ch;
    const bf16_t* g2 = Bt + (size_t)(cb + 32 + r0) * K + ch;
    const int l0 = r0 * 136 + ch;
    uint4 v0 = *(const uint4*)g0, v1 = *(const uint4*)g1, v2 = *(const uint4*)g2;
    *(uint4*)(sA + l0) = v0; *(uint4*)(sB + l0) = v1; *(uint4*)(sB + 32 * 136 + l0) = v2;
    __syncthreads();
    f32x4 acc = (f32x4){0.f, 0.f, 0.f, 0.f};
    const int nk = K >> 7;
    for (int kt = 0; kt < nk; ++kt) {
      const int buf = kt & 1;
      if (kt + 1 < nk) { v0 = *(const uint4*)(g0 + (kt + 1) * 128); v1 = *(const uint4*)(g1 + (kt + 1) * 128); v2 = *(const uint4*)(g2 + (kt + 1) * 128); }
      const bf16_t* cA = sA + buf * 32 * 136 + (mr * 16 + fr) * 136 + fq * 8;
      const bf16_t* cB = sB + buf * 64 * 136 + (nc * 16 + fr) * 136 + fq * 8;
#pragma unroll
      for (int ks = 0; ks < 4; ++ks) {
        bf16x8 a = *(const bf16x8*)(cA + ks * 32);
        bf16x8 b = *(const bf16x8*)(cB + ks * 32);
        acc = MFMA16(b, a, acc);
        asm volatile("" :: "v"(a), "v"(b));
      }
      if (kt + 1 < nk) {
        bf16_t* dA = sA + (buf ^ 1) * 32 * 136; bf16_t* dB = sB + (buf ^ 1) * 64 * 136;
        *(uint4*)(dA + l0) = v0; *(uint4*)(dB + l0) = v1; *(uint4*)(dB + 32 * 136 + l0) = v2;
      }
      __syncthreads();
    }
    const int row = rowb + mr * 16 + fr, cc = cb + nc * 16 + fq * 4;
    if (KIND == EPI_RESID) {
      float* xb = xrow(p, row);
      const float* md = p.mod() + ((size_t)e.layer * 3 + 2) * NMOD + e.slot * D;
      float4 gs = *(const float4*)(md + cc);
      float4 xv = *(float4*)(xb + cc);
      xv.x += e.scale * gs.x * acc[0]; xv.y += e.scale * gs.y * acc[1]; xv.z += e.scale * gs.z * acc[2]; xv.w += e.scale * gs.w * acc[3];
      *(float4*)(xb + cc) = xv;
    } else {
      uint2 o; o.x = pack2(acc[0], acc[1]); o.y = pack2(acc[2], acc[3]);
      *(uint2*)(e.outb + (size_t)row * e.ldo + cc) = o;
    }
  }
}

template <int EPI>
__device__ __forceinline__ void gemm_phase(const Params& p, const EpiArgs& ea, const bf16_t* A, int lda, const bf16_t* Bt, int K,
                           int Mtiles, int Ntiles, int a_mode, int rot, char* smem) {
  const int G = gridDim.x;
  const int ntiles = Mtiles * Ntiles;
  int vb = obid() - (rot % G); if (vb < 0) vb += G;
  const int nxcd = 8;
  const int per = G / nxcd;
  const int x = vb % nxcd, kk = vb / nxcd;
  for (int r = 0;; ++r) {
    int L = (r * nxcd + x) * per + kk;
    if (L >= ntiles) { if ((r * nxcd) * per >= ntiles) break; else continue; }
    int band = L / (4 * Ntiles);
    int rem = L - band * 4 * Ntiles;
    int bm = Mtiles - band * 4; if (bm > 4) bm = 4;
    int nt = rem / bm, mi = rem - nt * bm;
    int mt = band * 4 + mi;
    const bf16_t* Ap = A;
    if (a_mode == 1) Ap = A + (nt >> 1) * 128;
    gemm_tile<EPI>(p, ea, Ap, lda, Bt, K, mt * 256, nt * 128, smem);
  }
}

__device__ __forceinline__ int mchunk_tok(int dir, int j, int r) {
  if (dir == 0) return j * 64 + r;
  int c = (j < 4) ? (3 - j) : (135 - j);
  return c * 64 + 63 - r;
}

__device__ __forceinline__ void m1_phase(const Params& p, char* smem) {
  const int tid = otid(), lane = tid & 63, w = tid >> 6, fr = lane & 15, fq = lane >> 4;
  for (int row = obid() * 8 + w; row < NTOK; row += gridDim.x * 8) {
    const bf16_t* pr = p.ACT() + (size_t)row * PW;
    float sq = 0, skv = 0;
#pragma unroll
    for (int i = 0; i < 6; ++i) { float v = bf2f(pr[i * 64 + lane]); sq += v * v; }
#pragma unroll
    for (int i = 0; i < 4; ++i) { float v = bf2f(pr[384 + i * 64 + lane]); skv += v * v; }
    sq = wave_sum(sq); skv = wave_sum(skv);
    if (lane == 0) {
      p.RS()[(size_t)row * 2] = rsqrtf(sq * (1.0f / 384.0f) + 1e-6f);
      p.RS()[(size_t)row * 2 + 1] = rsqrtf(skv * (1.0f / 256.0f) + 1e-6f);
    }
    if (lane < 32) p.KR()[(size_t)row * 32 + lane] = pr[640 + lane];
  }
  bf16_t* Kt = (bf16_t*)smem;
  bf16_t* Vt = Kt + 128 * 72;
  float* wv = (float*)(Vt + 128 * 72);
  for (int it = obid(); it < NCHAIN * NCHUNK; it += gridDim.x) {
    int ci = it / NCHUNK, j = it - ci * NCHUNK;
    int dir = ci & 1, h = (ci >> 1) & 3, b = ci >> 3;
    int rowbase = b * TPB;
    float gi_raw = 0.f, gf_raw = 0.f;
    if (w == 0) {
      int row = rowbase + mchunk_tok(dir, j, lane);
      gi_raw = p.G()[(size_t)row * 16 + (2 * dir) * 4 + h];
      gf_raw = p.G()[(size_t)row * 16 + (2 * dir + 1) * 4 + h];
    }
    const int r_s = tid & 63, fc0 = (tid >> 6) * 8;
    uint4 kv0, kv1, vv0, vv1;
    {
      const bf16_t* src = p.ACT() + (size_t)(rowbase + mchunk_tok(dir, j, r_s)) * PW;
      kv0 = *(const uint4*)(src + 1184 + h * 128 + fc0); kv1 = *(const uint4*)(src + 1184 + h * 128 + fc0 + 64);
      vv0 = *(const uint4*)(src + 1696 + h * 128 + fc0); vv1 = *(const uint4*)(src + 1696 + h * 128 + fc0 + 64);
    }
    if (w == 0) {
      float gi = gi_raw + p.mlstm_gate_b[(2 * dir) * 4 + h];
      float gf = gf_raw + p.mlstm_gate_b[(2 * dir + 1) * 4 + h];
      float bsum = logsigmoidf_(gf);
#pragma unroll
      for (int o = 1; o < 64; o <<= 1) { float t = __shfl_up(bsum, o); if (lane >= o) bsum += t; }
      float be = __shfl(bsum, 63);
      float gg = be - bsum + gi;
      float ml = wave_max(gg);
      wv[lane] = __expf(gg - ml);
      if (lane == 0) { p.mloc()[it] = ml; p.bend()[it] = be; }
    }
    __syncthreads();
    {
      const float wr = wv[r_s];
      const bf16_t* ke0 = (const bf16_t*)&kv0; const bf16_t* ke1 = (const bf16_t*)&kv1;
      const bf16_t* ve0 = (const bf16_t*)&vv0; const bf16_t* ve1 = (const bf16_t*)&vv1;
#pragma unroll
      for (int e = 0; e < 8; ++e) {
        Kt[(fc0 + e) * 72 + r_s] = ke0[e];
        Kt[(fc0 + 64 + e) * 72 + r_s] = ke1[e];
        Vt[(fc0 + e) * 72 + r_s] = f2bf(bf2f(ve0[e]) * wr);
        Vt[(fc0 + 64 + e) * 72 + r_s] = f2bf(bf2f(ve1[e]) * wr);
      }
    }
    __syncthreads();
    f32x4 acc[8];
#pragma unroll
    for (int ni = 0; ni < 8; ++ni) acc[ni] = (f32x4){0.f, 0.f, 0.f, 0.f};
#pragma unroll
    for (int ks = 0; ks < 2; ++ks) {
      bf16x8 a = *(const bf16x8*)(Vt + (w * 16 + fr) * 72 + ks * 32 + fq * 8);
#pragma unroll
      for (int ni = 0; ni < 8; ++ni) {
        bf16x8 bb = *(const bf16x8*)(Kt + (ni * 16 + fr) * 72 + ks * 32 + fq * 8);
        acc[ni] = MFMA16(a, bb, acc[ni]);
      }
    }
    bf16_t* dC = p.R() + (size_t)it * 16384;
#pragma unroll
    for (int ni = 0; ni < 8; ++ni)
#pragma unroll
      for (int jj = 0; jj < 4; ++jj) dC[(w * 16 + fq * 4 + jj) * 128 + ni * 16 + fr] = f2bf(acc[ni][jj]);
    if (tid < 128) {
      float s = 0;
#pragma unroll 8
      for (int r = 0; r < 64; ++r) s += wv[r] * bf2f(Kt[tid * 72 + r]);
      p.dn()[(size_t)it * 128 + tid] = s;
    }
    __syncthreads();
  }
}

__device__ __forceinline__ void m2_phase(const Params& p) {
  const int tid = otid();
  for (int it = obid(); it < NCHAIN * 16; it += gridDim.x) {
    int ci = it >> 4, sl = it & 15;
    float C0 = 0, C1 = 0, m = 0, nn = 0;
    const bool don = (sl == 0 && tid < 128);
    uint32_t* base = (uint32_t*)(p.R() + (size_t)ci * NCHUNK * 16384 + sl * 1024) + tid;
    constexpr int GRP = 33;
#pragma unroll 1
    for (int j0 = 0; j0 < NCHUNK; j0 += GRP) {
      uint32_t d[GRP]; float ml[GRP], be[GRP], dnv[GRP];
#pragma unroll
      for (int q = 0; q < GRP; ++q) {
        int sidx = ci * NCHUNK + j0 + q;
        d[q] = base[(size_t)(j0 + q) * 8192];
        ml[q] = p.mloc()[sidx]; be[q] = p.bend()[sidx];
        dnv[q] = don ? p.dn()[(size_t)sidx * 128 + tid] : 0.0f;
      }
#pragma unroll
      for (int q = 0; q < GRP; ++q) {
        int sidx = ci * NCHUNK + j0 + q;
        base[(size_t)(j0 + q) * 8192] = pack2(C0, C1);
        if (don) p.nst()[(size_t)sidx * 128 + tid] = nn;
        if (sl == 0 && tid == 0) p.mst()[sidx] = m;
        float mn = fmaxf(be[q] + m, ml[q]);
        float a = __expf(be[q] + m - mn), bb = __expf(ml[q] - mn);
        C0 = a * C0 + bb * lo2f(d[q]);
        C1 = a * C1 + bb * hi2f(d[q]);
        nn = a * nn + bb * dnv[q];
        m = mn;
      }
    }
  }
}

__device__ __forceinline__ void m3_phase(const Params& p, char* smem) {
  const int tid = otid(), lane = tid & 63, w = tid >> 6, fr = lane & 15, fq = lane >> 4;
  bf16_t* Qs = (bf16_t*)smem;
  bf16_t* Ks = Qs + 64 * 136;
  bf16_t* Vt = Ks + 64 * 136;
  bf16_t* Cs = Vt + 128 * 72;
  bf16_t* Sw = Cs + 128 * 136;
  float* hs = (float*)(Sw + 64 * 72);
  float* cs = hs + 64 * 132;
  float* rt = cs + 64;
  float* wint = rt + 64;
  float* emt = wint + 64;
  float* qn = emt + 64;
  float* denp = qn + 64;
  float* ns = denp + 128;
  bf16_t* MIX = p.H();
  for (int it = obid(); it < 8 * NCHUNK; it += gridDim.x) {
    int bh = it / NCHUNK, c = it - bh * NCHUNK;
    int b = bh >> 2, h = bh & 3;
    int rowbase = b * TPB;
    for (int dir = 0; dir < 2; ++dir) {
      int ci = (b * 4 + h) * 2 + dir;
      int j = (dir == 0) ? c : ((c < 4) ? (3 - c) : (135 - c));
      int sidx = ci * NCHUNK + j;
      float gi_raw = 0.f, gf_raw = 0.f, mprev = 0.f;
      if (w == 0) {
        int row = rowbase + mchunk_tok(dir, j, lane);
        gi_raw = p.G()[(size_t)row * 16 + (2 * dir) * 4 + h];
        gf_raw = p.G()[(size_t)row * 16 + (2 * dir + 1) * 4 + h];
        mprev = p.mst()[sidx];
      }
      if (tid < 128) ns[tid] = p.nst()[(size_t)sidx * 128 + tid];
#pragma unroll
      for (int i = 0; i < 2; ++i) {
        int idx = tid + i * NTHR;
        int r = idx & 63, fc = (idx >> 6) * 8;
        int row = rowbase + mchunk_tok(dir, j, r);
        const bf16_t* src = p.ACT() + (size_t)row * PW;
        uint4 qv = *(const uint4*)(src + 672 + h * 128 + fc);
        uint4 kv = *(const uint4*)(src + 1184 + h * 128 + fc);
        uint4 vv = *(const uint4*)(src + 1696 + h * 128 + fc);
        *(uint4*)(Qs + r * 136 + fc) = qv;
        *(uint4*)(Ks + r * 136 + fc) = kv;
        const bf16_t* ve = (const bf16_t*)&vv;
#pragma unroll
        for (int e = 0; e < 8; ++e) Vt[(fc + e) * 72 + r] = ve[e];
      }
      {
        const bf16_t* cst = p.R() + (size_t)sidx * 16384;
#pragma unroll
        for (int i = 0; i < 4; ++i) {
          int idx = tid + i * NTHR;
          int v = idx >> 4, kc = (idx & 15) * 8;
          *(uint4*)(Cs + v * 136 + kc) = *(const uint4*)(cst + v * 128 + kc);
        }
      }
      if (w == 0) {
        float gi = gi_raw + p.mlstm_gate_b[(2 * dir) * 4 + h];
        float gf = gf_raw + p.mlstm_gate_b[(2 * dir + 1) * 4 + h];
        float bsum = logsigmoidf_(gf);
#pragma unroll
        for (int o = 1; o < 64; o <<= 1) { float t = __shfl_up(bsum, o); if (lane >= o) bsum += t; }
        float cv = gi - bsum;
        float pm = cv;
#pragma unroll
        for (int o = 1; o < 64; o <<= 1) { float t = __shfl_up(pm, o); if (lane >= o) pm = fmaxf(pm, t); }
        float mt = fmaxf(bsum + mprev, bsum + pm);
        cs[lane] = cv;
        rt[lane] = bsum - mt;
        wint[lane] = __expf(bsum + mprev - mt);
        emt[lane] = __expf(-mt);
      }
      __syncthreads();
      {
        const int mi = w & 3, nb2 = (w >> 2) * 2;
        f32x4 s2[2] = {(f32x4){0.f, 0.f, 0.f, 0.f}, (f32x4){0.f, 0.f, 0.f, 0.f}};
#pragma unroll
        for (int ks = 0; ks < 4; ++ks) {
          bf16x8 a = *(const bf16x8*)(Qs + (mi * 16 + fr) * 136 + ks * 32 + fq * 8);
#pragma unroll
          for (int q = 0; q < 2; ++q) {
            bf16x8 bb = *(const bf16x8*)(Ks + ((nb2 + q) * 16 + fr) * 136 + ks * 32 + fq * 8);
            s2[q] = MFMA16(a, bb, s2[q]);
          }
        }
        float rsum[4] = {0, 0, 0, 0};
#pragma unroll
        for (int q = 0; q < 2; ++q) {
          int s = (nb2 + q) * 16 + fr;
          float csv = cs[s];
#pragma unroll
          for (int jj = 0; jj < 4; ++jj) {
            int t = mi * 16 + fq * 4 + jj;
            float wgt = (s <= t) ? __expf(rt[t] + csv) : 0.0f;
            bf16_t hb = f2bf(s2[q][jj] * wgt);
            Sw[t * 72 + s] = hb;
            rsum[jj] += bf2f(hb);
          }
        }
#pragma unroll
        for (int jj = 0; jj < 4; ++jj) {
          float v = rsum[jj];
          v += __shfl_xor(v, 1); v += __shfl_xor(v, 2); v += __shfl_xor(v, 4); v += __shfl_xor(v, 8);
          if (fr == 0) denp[(w >> 2) * 64 + mi * 16 + fq * 4 + jj] = v;
        }
        {
          int t = tid >> 3, k0 = (tid & 7) * 16;
          float s = 0;
#pragma unroll
          for (int k = 0; k < 16; ++k) s += bf2f(Qs[t * 136 + k0 + k]) * ns[k0 + k];
          s += __shfl_xor(s, 1); s += __shfl_xor(s, 2); s += __shfl_xor(s, 4);
          if ((tid & 7) == 0) qn[t] = s;
        }
      }
      __syncthreads();
      {
        const int mi = w & 3, nh = w >> 2;
        f32x4 a1[4], a2[4];
#pragma unroll
        for (int q = 0; q < 4; ++q) { a1[q] = (f32x4){0.f, 0.f, 0.f, 0.f}; a2[q] = (f32x4){0.f, 0.f, 0.f, 0.f}; }
#pragma unroll
        for (int ks = 0; ks < 2; ++ks) {
          bf16x8 a = *(const bf16x8*)(Sw + (mi * 16 + fr) * 72 + ks * 32 + fq * 8);
#pragma unroll
          for (int q = 0; q < 4; ++q) {
            bf16x8 bb = *(const bf16x8*)(Vt + ((nh * 4 + q) * 16 + fr) * 72 + ks * 32 + fq * 8);
            a1[q] = MFMA16(a, bb, a1[q]);
          }
        }
#pragma unroll
        for (int ks = 0; ks < 4; ++ks) {
          bf16x8 a = *(const bf16x8*)(Qs + (mi * 16 + fr) * 136 + ks * 32 + fq * 8);
#pragma unroll
          for (int q = 0; q < 4; ++q) {
            bf16x8 bb = *(const bf16x8*)(Cs + ((nh * 4 + q) * 16 + fr) * 136 + ks * 32 + fq * 8);
            a2[q] = MFMA16(a, bb, a2[q]);
          }
        }
#pragma unroll
        for (int jj = 0; jj < 4; ++jj) {
          int t = mi * 16 + fq * 4 + jj;
          float wi = wint[t];
          float den = denp[t] + denp[64 + t] + wi * qn[t];
          float inv = 1.0f / fmaxf(fabsf(den), emt[t]);
          int tl = (dir == 0) ? t : (63 - t);
#pragma unroll
          for (int q = 0; q < 4; ++q) {
            int v = (nh * 4 + q) * 16 + fr;
            float hv = (a1[q][jj] + wi * a2[q][jj]) * inv;
            if (dir == 0) hs[tl * 132 + v] = hv; else hs[tl * 132 + v] += hv;
          }
        }
      }
      __syncthreads();
    }
    for (int q = 0; q < 8; ++q) {
      int tl = w * 8 + q;
      float v0 = hs[tl * 132 + lane], v1 = hs[tl * 132 + 64 + lane];
      float ss = wave_sum(v0 * v0 + v1 * v1);
      float rstd = rsqrtf(ss * (1.0f / 128.0f) + 1e-6f);
      int row = rowbase + c * 64 + tl;
      const bf16_t* po = p.ACT() + (size_t)row * PW + 2208 + h * 128;
      float o0 = bf2f(po[lane]), o1 = bf2f(po[64 + lane]);
      float y0 = v0 * rstd * p.mlstm_out_g[h * 128 + lane] * sigmoidf_(o0);
      float y1 = v1 * rstd * p.mlstm_out_g[h * 128 + 64 + lane] * sigmoidf_(o1);
      MIX[(size_t)row * D + 512 + h * 128 + lane] = f2bf(y0);
      MIX[(size_t)row * D + 512 + h * 128 + 64 + lane] = f2bf(y1);
    }
    __syncthreads();
  }
}

__device__ __forceinline__ void norm_rope_32(float* x, const float* g, bool latent, int t, const float2* tab) {
  float ss = 0;
#pragma unroll
  for (int i = 0; i < 32; ++i) ss += x[i] * x[i];
  float rstd = rsqrtf(ss * (1.0f / 32.0f) + 1e-6f);
#pragma unroll
  for (int i = 0; i < 32; ++i) x[i] = x[i] * rstd * g[i];
  if (latent) {
#pragma unroll
    for (int a = 0; a < 2; ++a) {
      const int pos = (a == 0 ? (t >> 6) : (t & 63));
#pragma unroll
      for (int i = 0; i < 8; ++i) {
        float2 cs = tab[pos * 8 + i];
        float x1 = x[a * 16 + i], x2 = x[a * 16 + 8 + i];
        x[a * 16 + i] = x1 * cs.x - x2 * cs.y;
        x[a * 16 + 8 + i] = x2 * cs.x + x1 * cs.y;
      }
    }
  }
}

__device__ __forceinline__ void load32(const bf16_t* src, float* x) {
  const uint4* s4 = (const uint4*)src;
#pragma unroll
  for (int i = 0; i < 4; ++i) {
    uint4 v = s4[i];
    x[i * 8 + 0] = lo2f(v.x); x[i * 8 + 1] = hi2f(v.x); x[i * 8 + 2] = lo2f(v.y); x[i * 8 + 3] = hi2f(v.y);
    x[i * 8 + 4] = lo2f(v.z); x[i * 8 + 5] = hi2f(v.z); x[i * 8 + 6] = lo2f(v.w); x[i * 8 + 7] = hi2f(v.w);
  }
}
__device__ __forceinline__ void post_phase(const Params& p) {
  const bf16_t* QRAW = p.R();
  const bf16_t* KVRAW = p.R() + (size_t)NTOK * 768;
  bf16_t* Qo = p.ACT();
  bf16_t* Ko = p.ACT() + (size_t)16 * TPB * 96;
  const float qscale = 0.10206207261596577f * 1.4426950408889634f;
  const int tid = otid();
  for (int gi = obid() * NTHR + tid; gi < 4 * NTOK * 8; gi += gridDim.x * NTHR) {
    const int part = gi / (NTOK * 8);
    const int idx = gi - part * (NTOK * 8);
    int row = idx >> 3, h = idx & 7;
    int b = row >= TPB ? 1 : 0, u = row - b * TPB;
    bool latent = u >= CTX; int t = u - CTX;
    size_t obase = ((size_t)(b * 8 + h) * TPB + u) * 96;
    float knorm2 = 0.f;
    if (part < 2) {
      const bf16_t* src = part == 0 ? QRAW + (size_t)row * 768 + h * 96 : KVRAW + (size_t)row * 1024 + h * 128;
      const float* gn = part == 0 ? p.mla_q_g : p.mla_k_g;
      float x[64]; float ss = 0;
      load32(src, x); load32(src + 32, x + 32);
#pragma unroll
      for (int i = 0; i < 64; ++i) ss += x[i] * x[i];
      float rstd = rsqrtf(ss * (1.0f / 64.0f) + 1e-6f) * (part == 0 ? qscale : 1.0f);
      uint4* dst = (uint4*)((part == 0 ? Qo : Ko) + obase);
#pragma unroll
      for (int i = 0; i < 8; ++i) {
        float y[8];
#pragma unroll
        for (int e = 0; e < 8; ++e) { y[e] = x[i * 8 + e] * rstd * gn[i * 8 + e]; knorm2 += y[e] * y[e]; }
        uint4 o;
        o.x = pack2(y[0], y[1]); o.y = pack2(y[2], y[3]); o.z = pack2(y[4], y[5]); o.w = pack2(y[6], y[7]);
        dst[i] = o;
      }
    } else {
      const bf16_t* src = part == 2 ? QRAW + (size_t)row * 768 + h * 96 + 64 : p.KR() + (size_t)row * 32;
      float x[32];
      load32(src, x);
      norm_rope_32(x, (part == 2 ? p.mla_q_g : p.mla_k_g) + 64, latent, t, p.ropetab());
      const float sc = part == 2 ? qscale : 1.0f;
      uint4* dst = (uint4*)((part == 2 ? Qo : Ko) + obase + 64);
#pragma unroll
      for (int i = 0; i < 4; ++i) {
        float y[8];
#pragma unroll
        for (int e = 0; e < 8; ++e) { y[e] = x[i * 8 + e] * sc; knorm2 += y[e] * y[e]; }
        uint4 o;
        o.x = pack2(y[0], y[1]); o.y = pack2(y[2], y[3]); o.z = pack2(y[4], y[5]); o.w = pack2(y[6], y[7]);
        dst[i] = o;
      }
    }
    if (part == 1 || part == 3) {
      knorm2 = fmaxf(knorm2, __shfl_xor(knorm2, 8));
      knorm2 = fmaxf(knorm2, __shfl_xor(knorm2, 16));
      knorm2 = fmaxf(knorm2, __shfl_xor(knorm2, 32));
      if ((tid & 63) < 8) atomicMax(p.kmax2() + (part == 1 ? 0 : 16) + (b * 8 + h), __float_as_uint(knorm2));
    }
  }
}

__device__ __forceinline__ void vt_scatter(bf16_t* dst, int stride, uint4 v) {
  dst[0 * stride] = (bf16_t)(v.x & 0xFFFF); dst[1 * stride] = (bf16_t)(v.x >> 16);
  dst[2 * stride] = (bf16_t)(v.y & 0xFFFF); dst[3 * stride] = (bf16_t)(v.y >> 16);
  dst[4 * stride] = (bf16_t)(v.z & 0xFFFF); dst[5 * stride] = (bf16_t)(v.z >> 16);
  dst[6 * stride] = (bf16_t)(v.w & 0xFFFF); dst[7 * stride] = (bf16_t)(v.w >> 16);
}
constexpr int KLD = 104, VLD = 136, KT = 128;
__device__ __forceinline__ void attn_phase(const Params& p, char* smem) {
  const int tid = otid(), lane = tid & 63, w = tid >> 6, fr = lane & 15, fq = lane >> 4;
  bf16_t* Ks = (bf16_t*)smem;
  bf16_t* Vt = Ks + 2 * KT * KLD;
  const bf16_t* Qg = p.ACT();
  const bf16_t* Kg = p.ACT() + (size_t)16 * TPB * 96;
  const bf16_t* KVRAW = p.R() + (size_t)NTOK * 768;
  bf16_t* MIX = p.H();
  for (int it = obid(); it < 272; it += gridDim.x) {
    int bh, qu0, nq, nkeys;
    if (it < 256) { int xx = it & 7, k = it >> 3; bh = 2 * xx + (k >> 4); qu0 = CTX + (k & 15) * 512; nq = 512; nkeys = TPB; }
    else { bh = it - 256; qu0 = 0; nq = 256; nkeys = CTX; }
    const int b = bh >> 3, h = bh & 7;
    const bool active = (w * 64) < nq;
    bf16x8 qf[4][3];
    if (active) {
#pragma unroll
      for (int g = 0; g < 4; ++g) {
        const bf16_t* qp = Qg + ((size_t)bh * TPB + qu0 + w * 64 + g * 16 + fr) * 96 + fq * 8;
#pragma unroll
        for (int ds = 0; ds < 3; ++ds) qf[g][ds] = *(const bf16x8*)(qp + ds * 32);
      }
    }
    f32x4 oT[4][4];
    float mneg[4], lrun[4];
    float bmax = 0.f;
    {
      const float kmx = sqrtf(__uint_as_float(p.kmax2()[bh]) + __uint_as_float(p.kmax2()[16 + bh])) * 1.01f;
#pragma unroll
      for (int g = 0; g < 4; ++g) {
        float qs = 0.f;
        if (active) {
#pragma unroll
          for (int ds = 0; ds < 3; ++ds)
#pragma unroll
            for (int e = 0; e < 8; ++e) { float qv = bf2f((bf16_t)qf[g][ds][e]); qs += qv * qv; }
        }
        qs += __shfl_xor(qs, 16); qs += __shfl_xor(qs, 32);
        mneg[g] = -sqrtf(qs) * kmx;
        bmax = fmaxf(bmax, -mneg[g]);
        lrun[g] = 0.f;
#pragma unroll
        for (int q = 0; q < 4; ++q) oT[g][q] = (f32x4){0.f, 0.f, 0.f, 0.f};
      }
    }
    const bool stab = __any(bmax > 60.0f) != 0;
    const bf16_t* kbase = Kg + (size_t)bh * TPB * 96;
    const bf16_t* vbase = KVRAW + (size_t)b * TPB * 1024 + h * 128 + 64;
#define kgo ((tid >> 2) * 96 + (tid & 3) * 24)
#define klo ((tid >> 2) * KLD + (tid & 3) * 24)
#define vkey0 (tid >> 3)
#define vch (tid & 7)
    uint4 rk0, rk1, rk2, rv0, rv1;
    const int nkt = nkeys / KT;
    rk0 = *(const uint4*)(kbase + kgo); rk1 = *(const uint4*)(kbase + kgo + 8); rk2 = *(const uint4*)(kbase + kgo + 16);
    rv0 = *(const uint4*)(vbase + (size_t)vkey0 * 1024 + vch * 8); rv1 = *(const uint4*)(vbase + (size_t)(vkey0 + 64) * 1024 + vch * 8);
    {
      *(uint4*)(Ks + klo) = rk0; *(uint4*)(Ks + klo + 8) = rk1; *(uint4*)(Ks + klo + 16) = rk2;
      vt_scatter(Vt + (vch * 8) * VLD + vkey0, VLD, rv0); vt_scatter(Vt + (vch * 8) * VLD + vkey0 + 64, VLD, rv1);
    }
    __syncthreads();
    for (int kt = 0; kt < nkt; ++kt) {
      const int buf = kt & 1;
      if (kt + 1 < nkt) {
        size_t ko = (size_t)(kt + 1) * KT;
        rk0 = *(const uint4*)(kbase + ko * 96 + kgo); rk1 = *(const uint4*)(kbase + ko * 96 + kgo + 8); rk2 = *(const uint4*)(kbase + ko * 96 + kgo + 16);
        rv0 = *(const uint4*)(vbase + (ko + vkey0) * 1024 + vch * 8); rv1 = *(const uint4*)(vbase + (ko + vkey0 + 64) * 1024 + vch * 8);
      }
      if (active) {
        const bf16_t* cK = Ks + buf * KT * KLD;
        const bf16_t* cV = Vt + buf * 64 * VLD;
#pragma unroll 1
        for (int ks = 0; ks < 4; ++ks) {
          uint32_t pfu[4][4];
#pragma unroll
          for (int kf = 0; kf < 2; ++kf) {
            f32x4 sT[4];
#pragma unroll
            for (int g = 0; g < 4; ++g) sT[g] = (f32x4){0.f, 0.f, 0.f, 0.f};
#pragma unroll
            for (int ds = 0; ds < 3; ++ds) {
              bf16x8 ka = *(const bf16x8*)(cK + (ks * 32 + kf * 16 + fr) * KLD + ds * 32 + fq * 8);
#pragma unroll
              for (int g = 0; g < 4; ++g) sT[g] = MFMA16(ka, qf[g][ds], sT[g]);
            }
            if (stab) {
#pragma unroll
              for (int g = 0; g < 4; ++g) { sT[g][0] += mneg[g]; sT[g][1] += mneg[g]; sT[g][2] += mneg[g]; sT[g][3] += mneg[g]; }
            }
#pragma unroll
            for (int g = 0; g < 4; ++g) {
              float p0 = __builtin_amdgcn_exp2f(sT[g][0]), p1 = __builtin_amdgcn_exp2f(sT[g][1]);
              float p2 = __builtin_amdgcn_exp2f(sT[g][2]), p3 = __builtin_amdgcn_exp2f(sT[g][3]);
              { float l_ = lrun[g]; l_ += p0; l_ += p1; l_ += p2; l_ += p3; lrun[g] = l_; }
              pfu[g][kf * 2] = pack2(p0, p1); pfu[g][kf * 2 + 1] = pack2(p2, p3);
            }
          }
          bf16x8 pf[4];
#pragma unroll
          for (int g = 0; g < 4; ++g) {
            union { uint32_t u[4]; bf16x8 v; } cvt;
            cvt.u[0] = pfu[g][0]; cvt.u[1] = pfu[g][1]; cvt.u[2] = pfu[g][2]; cvt.u[3] = pfu[g][3];
            pf[g] = cvt.v;
          }
#pragma unroll
          for (int dvf = 0; dvf < 4; ++dvf) {
            const bf16_t* vp = cV + (dvf * 16 + fr) * VLD + ks * 32 + fq * 4;
            union { uint2 u[2]; bf16x8 v; } va;
            va.u[0] = *(const uint2*)(vp);
            va.u[1] = *(const uint2*)(vp + 16);
#pragma unroll
            for (int g = 0; g < 4; ++g) oT[g][dvf] = MFMA16(va.v, pf[g], oT[g][dvf]);
          }
        }
      }
      if (kt + 1 < nkt) {
        bf16_t* dK = Ks + (buf ^ 1) * KT * KLD;
        bf16_t* dV = Vt + (buf ^ 1) * 64 * VLD;
        *(uint4*)(dK + klo) = rk0; *(uint4*)(dK + klo + 8) = rk1; *(uint4*)(dK + klo + 16) = rk2;
        vt_scatter(dV + (vch * 8) * VLD + vkey0, VLD, rv0); vt_scatter(dV + (vch * 8) * VLD + vkey0 + 64, VLD, rv1);
      }
      __syncthreads();
    }
    if (active) {
#pragma unroll
      for (int g = 0; g < 4; ++g) {
        float l = lrun[g];
        l += __shfl_xor(l, 16); l += __shfl_xor(l, 32);
        float inv = 1.0f / l;
        int row = b * TPB + qu0 + w * 64 + g * 16 + fr;
#pragma unroll
        for (int dvf = 0; dvf < 4; ++dvf) {
          uint2 o;
          o.x = pack2(oT[g][dvf][0] * inv, oT[g][dvf][1] * inv);
          o.y = pack2(oT[g][dvf][2] * inv, oT[g][dvf][3] * inv);
          *(uint2*)(MIX + (size_t)row * D + h * 64 + dvf * 16 + fq * 4) = o;
        }
      }
    }
  }
}

#undef kgo
#undef klo
#undef vkey0
#undef vch
__device__ __forceinline__ void conv_phase(const Params& p) {
  const bf16_t* O1 = p.ACT();
  for (int idx = obid() * NTHR + otid(); idx < NTOK * 128; idx += gridDim.x * NTHR) {
    int row = idx >> 7, cc = (idx & 127) * 8;
    int b = row >= TPB ? 1 : 0, u = row - b * TPB;
    int lo = (u < CTX) ? 0 : CTX, hi = (u < CTX) ? CTX : TPB;
    float acc[8];
#pragma unroll
    for (int e = 0; e < 8; ++e) acc[e] = p.odd_conv_b[cc + e];
#pragma unroll
    for (int k = 0; k < 4; ++k) {
      int uu = u + k - 2;
      if (uu >= lo && uu < hi) {
        uint4 v = *(const uint4*)(O1 + (size_t)(row + k - 2) * 2048 + 1024 + cc);
        const float* wk = p.odd_conv_w + k * 1024 + cc;
        acc[0] += wk[0] * lo2f(v.x); acc[1] += wk[1] * hi2f(v.x);
        acc[2] += wk[2] * lo2f(v.y); acc[3] += wk[3] * hi2f(v.y);
        acc[4] += wk[4] * lo2f(v.z); acc[5] += wk[5] * hi2f(v.z);
        acc[6] += wk[6] * lo2f(v.w); acc[7] += wk[7] * hi2f(v.w);
      }
    }
    uint4 o;
    o.x = pack2(acc[0], acc[1]); o.y = pack2(acc[2], acc[3]); o.z = pack2(acc[4], acc[5]); o.w = pack2(acc[6], acc[7]);
    *(uint4*)(p.XC() + (size_t)row * D + cc) = o;
  }
}

__device__ __forceinline__ int scan_tok(int dir, int pi) {
  if (dir == 0) return pi;
  return (pi < CTX) ? (CTX - 1 - pi) : (TPB + CTX - 1 - pi);
}

__device__ __forceinline__ void scan_step4(uint4 v, float (&h)[4]) {
  h[0] = __expf(lo2f(v.x)) * h[0] + hi2f(v.x);
  h[1] = __expf(lo2f(v.y)) * h[1] + hi2f(v.y);
  h[2] = __expf(lo2f(v.z)) * h[2] + hi2f(v.z);
  h[3] = __expf(lo2f(v.w)) * h[3] + hi2f(v.w);
}
__device__ __forceinline__ void scan1_phase(const Params& p, int dir) {
  const int tid = otid(), lane = tid & 63, w = tid >> 6;
  const uint32_t* RG = (const uint32_t*)p.R();
  float* const suma = p.SUMA(); float* const sumh = p.SUMH();
  for (int it = obid(); it < 256; it += gridDim.x) {
    const int b = it >> 7, cgp = (it >> 5) & 3, seg = it & 31;
    const int ch0 = cgp * 256 + lane * 4;
    const size_t rb = (size_t)b * TPB;
    const int pos0 = seg * 264 + w * 33;
    float h[4] = {0.f, 0.f, 0.f, 0.f}, as[4] = {0.f, 0.f, 0.f, 0.f};
    {
      uint4 v[33];
#pragma unroll
      for (int i = 0; i < 33; ++i) v[i] = *(const uint4*)(RG + (rb + scan_tok(dir, pos0 + i)) * D + ch0);
#pragma unroll
      for (int i = 0; i < 33; ++i) {
        scan_step4(v[i], h);
        as[0] += lo2f(v[i].x); as[1] += lo2f(v[i].y); as[2] += lo2f(v[i].z); as[3] += lo2f(v[i].w);
      }
    }
    const size_t e = ((size_t)(b * 4 + cgp) * 264 + seg * 8 + w) * 256 + lane * 4;
    *(float4*)(suma + e) = make_float4(as[0], as[1], as[2], as[3]);
    *(float4*)(sumh + e) = make_float4(h[0], h[1], h[2], h[3]);
  }
}
__device__ __forceinline__ void scan2_phase(const Params& p, int dir, char* smem) {
  const int tid = otid(), lane = tid & 63, w = tid >> 6;
  const uint32_t* RG = (const uint32_t*)p.R();
  float* const suma = p.SUMA(); float* const sumh = p.SUMH();
  const bf16_t* O1 = p.ACT();
  bf16_t* Y = p.H();
  float4* pA = (float4*)smem;
  float4* pH = pA + 512;
  for (int it = obid(); it < 256; it += gridDim.x) {
    const int b = it >> 7, cgp = (it >> 5) & 3, seg = it & 31;
    const int ch0 = cgp * 256 + lane * 4;
    const size_t rb = (size_t)b * TPB;
    const int pos0 = seg * 264 + w * 33;
    const size_t sb = ((size_t)(b * 4 + cgp) * 264) * 256 + lane * 4;
    {
      float a4[4] = {0.f, 0.f, 0.f, 0.f}, h4[4] = {0.f, 0.f, 0.f, 0.f};
#pragma unroll 1
      for (int q0 = 0; q0 < seg; q0 += 16) {
        float4 A[16], Hh[16];
#pragma unroll
        for (int i = 0; i < 16; ++i) {
          A[i] = make_float4(0.f, 0.f, 0.f, 0.f); Hh[i] = A[i];
          if (q0 + i < seg) { size_t e = sb + (size_t)(w * seg + q0 + i) * 256; A[i] = *(const float4*)(suma + e); Hh[i] = *(const float4*)(sumh + e); }
        }
#pragma unroll
        for (int i = 0; i < 16; ++i) {
          h4[0] = __expf(A[i].x) * h4[0] + Hh[i].x; h4[1] = __expf(A[i].y) * h4[1] + Hh[i].y; h4[2] = __expf(A[i].z) * h4[2] + Hh[i].z; h4[3] = __expf(A[i].w) * h4[3] + Hh[i].w;
          a4[0] += A[i].x; a4[1] += A[i].y; a4[2] += A[i].z; a4[3] += A[i].w;
        }
      }
      pA[w * 64 + lane] = make_float4(a4[0], a4[1], a4[2], a4[3]);
      pH[w * 64 + lane] = make_float4(h4[0], h4[1], h4[2], h4[3]);
    }
    __syncthreads();
    float h[4] = {0.f, 0.f, 0.f, 0.f};
#pragma unroll
    for (int q = 0; q < 8; ++q) {
      float4 A = pA[q * 64 + lane], Hh = pH[q * 64 + lane];
      h[0] = __expf(A.x) * h[0] + Hh.x; h[1] = __expf(A.y) * h[1] + Hh.y; h[2] = __expf(A.z) * h[2] + Hh.z; h[3] = __expf(A.w) * h[3] + Hh.w;
    }
    {
      float4 A[7], Hh[7];
#pragma unroll
      for (int q = 0; q < 7; ++q) {
        A[q] = make_float4(0.f, 0.f, 0.f, 0.f); Hh[q] = A[q];
        if (q < w) { size_t e = sb + (size_t)(seg * 8 + q) * 256; A[q] = *(const float4*)(suma + e); Hh[q] = *(const float4*)(sumh + e); }
      }
#pragma unroll
      for (int q = 0; q < 7; ++q) {
        h[0] = __expf(A[q].x) * h[0] + Hh[q].x; h[1] = __expf(A[q].y) * h[1] + Hh[q].y; h[2] = __expf(A[q].z) * h[2] + Hh[q].z; h[3] = __expf(A[q].w) * h[3] + Hh[q].w;
      }
    }
#pragma unroll 1
    for (int bt = 0; bt < 3; ++bt) {
      uint4 v[11]; uint2 hf[11], gt[11];
#pragma unroll
      for (int i = 0; i < 11; ++i) {
        size_t row = rb + scan_tok(dir, pos0 + bt * 11 + i);
        v[i] = *(const uint4*)(RG + row * D + ch0);
        if (dir == 1) { hf[i] = *(const uint2*)(Y + row * D + ch0); gt[i] = *(const uint2*)(O1 + row * 2048 + ch0); }
      }
#pragma unroll
      for (int i = 0; i < 11; ++i) {
        size_t row = rb + scan_tok(dir, pos0 + bt * 11 + i);
        scan_step4(v[i], h);
        uint2 o;
        if (dir == 0) { o.x = pack2(h[0], h[1]); o.y = pack2(h[2], h[3]); }
        else {
          float y0 = (lo2f(hf[i].x) + h[0]) * gelu_tanh(lo2f(gt[i].x));
          float y1 = (hi2f(hf[i].x) + h[1]) * gelu_tanh(hi2f(gt[i].x));
          float y2 = (lo2f(hf[i].y) + h[2]) * gelu_tanh(lo2f(gt[i].y));
          float y3 = (hi2f(hf[i].y) + h[3]) * gelu_tanh(hi2f(gt[i].y));
          o.x = pack2(y0, y1); o.y = pack2(y2, y3);
        }
        *(uint2*)(Y + row * D + ch0) = o;
      }
    }
    __syncthreads();
  }
}

#define XB_TMO      128
#define XB_XCNT(j)  (256  + 64 * (j))
#define XB_XSUB(j)  (1280 + 64 * (j))
#define XB_XGEN(j)  (2304 + 64 * (j))
#define XB_TOP      3328
#define XB_TOPGEN   3392
#define XCD_BAR_WORDS 3456
#define XB_SPIN_CAP (1u << 18)
#define LAS3 __attribute__((address_space(3)))
__device__ __forceinline__ unsigned xb_ld(unsigned* p)              { return __hip_atomic_load(p, __ATOMIC_RELAXED, __HIP_MEMORY_SCOPE_AGENT); }
__device__ __forceinline__ unsigned xb_add(unsigned* p, unsigned v) { return __hip_atomic_fetch_add(p, v, __ATOMIC_RELAXED, __HIP_MEMORY_SCOPE_AGENT); }
__device__ __forceinline__ unsigned xb_xcc_id() { return (unsigned)__builtin_amdgcn_s_getreg((3 << 11) | 20) & 0xFu; }
#define XB_SPIN(cond, bar) do { unsigned _sp = 0; while (cond) { __builtin_amdgcn_s_sleep(1); \
    if ((++_sp & 255u) == 0u) { if (xb_ld(&(bar)[XB_TMO])) break; if (_sp > XB_SPIN_CAP) { atomicAdd(&(bar)[XB_TMO], 1u); break; } } } } while (0)
struct XcdBarrier { unsigned* bar; unsigned x; volatile LAS3 unsigned* st; };
__device__ __forceinline__ XcdBarrier xcd_barrier_post(unsigned* bar, volatile LAS3 unsigned* st) {
    XcdBarrier b; b.bar = bar; b.x = xb_xcc_id(); b.st = st;
    if (threadIdx.x == 0) (void)xb_add(&bar[XB_XCNT(b.x)], 1u);
    return b;
}
__device__ __forceinline__ void xcd_barrier_complete(unsigned* bar, unsigned x, unsigned& nloc, unsigned& nx) {
    const unsigned G = gridDim.x * gridDim.y * gridDim.z;
    unsigned sum, cnt, mine, sp = 0u;
    for (;;) {
        sum = 0u; cnt = 0u; mine = 0u;
#pragma unroll
        for (unsigned j = 0; j < 16; ++j) { const unsigned c = xb_ld(&bar[XB_XCNT(j)]); sum += c; cnt += (c > 0u) ? 1u : 0u; mine = (j == x) ? c : mine; }
        if (sum == G) break;
        __builtin_amdgcn_s_sleep(1);
        if ((++sp & 255u) == 0u) { if (xb_ld(&bar[XB_TMO])) break; if (sp > XB_SPIN_CAP) { atomicAdd(&bar[XB_TMO], 1u); break; } }
    }
    nloc = mine > 0u ? mine : 1u; nx = cnt > 0u ? cnt : 1u;
}
__device__ __forceinline__ void xcd_barrier(const XcdBarrier& b) {
    asm volatile("s_waitcnt vmcnt(0)" ::: "memory");
    __syncthreads();
    if (threadIdx.x == 0) {
        unsigned* bar = b.bar;
        __builtin_amdgcn_s_waitcnt(0);
        unsigned nloc = b.st[0], nx = b.st[1];
        if (nloc == 0u) { xcd_barrier_complete(bar, b.x, nloc, nx); b.st[0] = nloc; b.st[1] = nx; }
        const unsigned old = xb_add(&bar[XB_XSUB(b.x)], 1u);
        const unsigned gen = old / nloc;
        if (old + 1u == (gen + 1u) * nloc) {
            __builtin_amdgcn_fence(__ATOMIC_RELEASE, "agent");
            asm volatile("s_waitcnt vmcnt(0)" ::: "memory");
            const unsigned og = xb_add(&bar[XB_TOP], 1u);
            const unsigned tg = og / nx;
            if (og + 1u == (tg + 1u) * nx) xb_add(&bar[XB_TOPGEN], 1u);
            else XB_SPIN(xb_ld(&bar[XB_TOPGEN]) == tg, bar);
            __builtin_amdgcn_fence(__ATOMIC_ACQUIRE, "agent");
            xb_add(&bar[XB_XGEN(b.x)], 1u);
            asm volatile("s_waitcnt vmcnt(0)" ::: "memory");
        } else {
            XB_SPIN(xb_ld(&bar[XB_XGEN(b.x)]) == gen, bar);
            __builtin_amdgcn_fence(__ATOMIC_ACQUIRE, "agent");
            asm volatile("s_waitcnt vmcnt(0)" ::: "memory");
        }
    }
    __syncthreads();
}

constexpr int NPHASE = 32;
#ifndef PHMASK
#define PHMASK 0xFFFFFFFFu
#endif
#define PHEN(n) ((PHMASK >> (n)) & 1u)

enum { K_P0 = 0, K_NORMMOD, K_FFN_UP, K_FFN_DOWN, K_E1, K_M1, K_M2, K_M3, K_UQKV, K_POST, K_ATTN, K_WOUT, K_O1, K_CONV, K_LRU, K_SCAN1, K_SCAN2 };
struct PhDesc { unsigned char kind, a0, a1, pad; };
__device__ const PhDesc PHTAB[NPHASE] = {
  {K_P0, 0, 0, 0}, {K_NORMMOD, 0, 0, 1}, {K_FFN_UP, 0, 0, 0}, {K_FFN_DOWN, 0, 1, 1}, {K_NORMMOD, 0, 1, 0}, {K_E1, 0, 0, 0}, {K_M1, 0, 0, 0}, {K_M2, 0, 0, 0},
  {K_M3, 0, 0, 0}, {K_UQKV, 0, 0, 0}, {K_POST, 0, 0, 0}, {K_ATTN, 0, 0, 0}, {K_WOUT, 0, 1, 0}, {K_NORMMOD, 0, 2, 0}, {K_FFN_UP, 1, 0, 0}, {K_FFN_DOWN, 1, 1, 0},
  {K_NORMMOD, 1, 0, 0}, {K_FFN_UP, 2, 0, 0}, {K_FFN_DOWN, 2, 1, 0}, {K_NORMMOD, 1, 1, 0}, {K_O1, 0, 0, 0}, {K_CONV, 0, 0, 0}, {K_LRU, 0, 0, 0}, {K_SCAN1, 0, 0, 0},
  {K_SCAN2, 0, 0, 0}, {K_LRU, 1, 0, 0}, {K_SCAN1, 1, 0, 0}, {K_SCAN2, 1, 0, 0}, {K_WOUT, 1, 0, 0}, {K_NORMMOD, 1, 2, 0}, {K_FFN_UP, 3, 1, 0}, {K_FFN_DOWN, 3, 0, 0}};
#ifndef KMASK
#define KMASK 0xFFFFFFFFu
#endif
#define KEN(k) ((KMASK >> (k)) & 1u)

__device__ __forceinline__ void run_phase(const Params& p, int ph, char* smem) {
  EpiArgs ea{};
  FEpi fe{};
  const int kind = PHTAB[ph].kind, a0 = PHTAB[ph].a0, a1 = PHTAB[ph].a1, a2 = PHTAB[ph].pad;
  switch (kind) {
    case K_P0: if (!KEN(K_P0)) break; p0_phase(p, smem); break;
    case K_NORMMOD: if (!KEN(K_NORMMOD)) break; normmod_phase(p, a0, a1, a2); break;
    case K_FFN_UP: if (!KEN(K_FFN_UP)) break;
      fe.outb = p.ACT(); fe.ldo = DFF;
      fast_gemm<EPI_SWIGLU>(p, fe, p.H(), D, p.Wgu(a0), D, 22, a1, smem); break;
    case K_FFN_DOWN: if (!KEN(K_FFN_DOWN)) break;
      fe.layer = a0 >> 1; fe.slot = (a0 & 1) ? 8 : 2; fe.scale = 0.5f; fe.xin = a2 ? p.x : nullptr;
      fast_gemm<EPI_RESID>(p, fe, p.ACT(), DFF, p.Wd(a0), DFF, 4, 1, smem);
      if (a1) ctx_gemm<EPI_RESID>(p, fe, p.ACT(), DFF, p.Wd(a0), DFF, 0, 16, smem);
      break;
    case K_E1: if (!KEN(K_E1)) break; fe.outb = p.ACT(); fe.outf = p.G();
      fast_gemm<EPI_E1>(p, fe, p.H(), D, p.Wein(), D, 11, 0, smem); break;
    case K_M1: if (!KEN(K_M1)) break; m1_phase(p, smem); break;
    case K_M2: if (!KEN(K_M2)) break; m2_phase(p); break;
    case K_M3: if (!KEN(K_M3)) break; m3_phase(p, smem); break;
    case K_UQKV: if (!KEN(K_UQKV)) break;
      for (int q = 0; q < 2; ++q) {
        fe.outb = q ? p.R() + (size_t)NTOK * 768 : p.R(); fe.ldo = q ? 1024 : 768; fe.rs = p.RS() + q;
        fast_gemm<EPI_ROWSCALE>(p, fe, p.ACT() + (q ? 384 : 0), PW, q ? p.Wukv() : p.Wuq(), q ? 256 : 384, q ? 4 : 3, 0, smem);
      }
      break;
    case K_POST: if (!KEN(K_POST)) break; post_phase(p); break;
    case K_ATTN: if (!KEN(K_ATTN)) break; attn_phase(p, smem); break;
    case K_WOUT: if (!KEN(K_WOUT)) break; fe.layer = a0; fe.slot = 5; fe.scale = 1.0f;
      fast_gemm<EPI_RESID>(p, fe, p.H(), D, a0 ? p.Woout() : p.Weout(), D, 4, 1, smem);
      if (a1) ctx_gemm<EPI_RESID>(p, fe, p.H(), D, a0 ? p.Woout() : p.Weout(), D, 0, 16, smem);
      break;
    case K_O1: if (!KEN(K_O1)) break; fe.outb = p.ACT(); fe.ldo = 2048;
      fast_gemm<EPI_PLAIN>(p, fe, p.H(), D, p.Woin(), D, 8, 1, smem);
      ctx_gemm<EPI_PLAIN>(p, fe, p.H(), D, p.Woin(), D, 1024, 16, smem); break;
    case K_CONV: if (!KEN(K_CONV)) break; conv_phase(p); break;
    case K_LRU: if (!KEN(K_LRU)) break; ea.dir = a0; ea.outu = (uint32_t*)p.R();
      gemm_phase<EPI_LRU>(p, ea, p.XC(), D, p.Wlru(a0), 128, NTOK / 256, 16, 1, 0, smem); break;
    case K_SCAN1: if (!KEN(K_SCAN1)) break; scan1_phase(p, a0); break;
    case K_SCAN2: if (!KEN(K_SCAN2)) break; scan2_phase(p, a0, smem); break;
    default: break;
  }
}

__global__ void __launch_bounds__(NTHR) mega(Params p, int ph_lo, int ph_hi) {
  extern __shared__ __attribute__((aligned(16))) char smem[];
  cg::grid_group grid = cg::this_grid();
  volatile LAS3 unsigned* st = (volatile LAS3 unsigned*)((LAS3 unsigned char*)smem + SMEM_BYTES - 16);
  if (threadIdx.x == 0) { st[0] = 0u; st[1] = 0u; }
  if (blockIdx.x == 0) { for (int i = threadIdx.x; i < XCD_BAR_WORDS; i += NTHR) p.bar()[i] = 0u; if (threadIdx.x < 32) p.kmax2()[threadIdx.x] = 0u; }
  __syncthreads();
  XcdBarrier xb; xb.bar = p.bar(); xb.x = xb_xcc_id(); xb.st = st;
#pragma unroll 1
  for (int ph = 0; ph < ph_hi; ++ph) {
    {
      const __attribute__((address_space(4))) char* ka = (const __attribute__((address_space(4))) char*)__builtin_amdgcn_kernarg_segment_ptr();
      asm volatile("" : "+s"(ka));
      const Params& pk = *(const Params*)ka;
      run_phase(pk, ph, smem);
    }
    if (ph + 1 < ph_hi) {
      if (ph == 0) {
        grid.sync();
        if (threadIdx.x == 0) (void)xb_add(&xb.bar[XB_XCNT(xb.x)], 1u);
      } else xcd_barrier(xb);
    }
  }
}

extern "C" void kernel_launch(void* const* d_in, const int* in_sizes, int n_in, void* d_out, int out_size, void* d_ws,
                              size_t ws_size, hipStream_t stream) {
  static int grid_blocks = 0;
  if (grid_blocks == 0) {
    int dev = 0, cus = 0, per_cu = 0;
    hipGetDevice(&dev);
    hipDeviceGetAttribute(&cus, hipDeviceAttributeMultiprocessorCount, dev);
    if (hipFuncSetAttribute((const void*)mega, hipFuncAttributeMaxDynamicSharedMemorySize, SMEM_BYTES) != hipSuccess) {
      fprintf(stderr, "hipFuncSetAttribute failed\n"); grid_blocks = -1; return;
    }
    if (hipOccupancyMaxActiveBlocksPerMultiprocessor(&per_cu, (const void*)mega, NTHR, SMEM_BYTES) != hipSuccess || per_cu < 1) {
      fprintf(stderr, "occupancy query failed (%d)\n", per_cu); grid_blocks = -1; return;
    }
    grid_blocks = cus;
    grid_blocks -= grid_blocks % 8;
  }
  if (grid_blocks < 0) return;

  Params p{};
  const float** ins = (const float**)&p.x;
  for (int i = 0; i < 29; ++i) ins[i] = (const float*)d_in[i];
  p.out = (float*)d_out;
  p.ws = (char*)d_ws;
  if (WS_TOTAL > ws_size) { fprintf(stderr, "workspace too small: need %zu have %zu\n", (size_t)WS_TOTAL, ws_size); return; }

  int lo = 0, hi = NPHASE;
  void* args[] = {&p, &lo, &hi};
  hipError_t e = hipLaunchCooperativeKernel((const void*)mega, dim3(grid_blocks), dim3(NTHR), args, SMEM_BYTES, stream);
  if (e != hipSuccess) fprintf(stderr, "cooperative launch failed: %s (grid %d)\n", hipGetErrorString(e), grid_blocks);
}
```

```cpp
#include <hip/hip_runtime.h>
#include <hip/hip_cooperative_groups.h>
#include <stdint.h>
#include <stdio.h>
namespace cg = cooperative_groups;

typedef unsigned short bf16_t;
typedef __attribute__((ext_vector_type(8))) short bf16x8;
typedef __attribute__((ext_vector_type(4))) float f32x4;

constexpr int D = 1024;
constexpr int SEQ = 8192;
constexpr int CTX = 256;
constexpr int TPB = SEQ + CTX;
constexpr int NTOK = 2 * TPB;
constexpr int DFF = 2816;
constexpr int NMOD = 9 * D;
constexpr int PW = 2816;
constexpr int NCHUNK = TPB / 64;
constexpr int NCHAIN = 16;
constexpr int NTHR = 512;
constexpr int SMEM_BYTES = 140 * 1024;

struct WDesc {
  const float* src; bf16_t* dst; const float* kscale;
  int K, N, ntn, nkt, nb, mode, item_start, pad;
};
constexpr int NWD = 22;
constexpr int N_WITEMS = 5220;

constexpr size_t al256(size_t x) { return (x + 255) & ~(size_t)255; }
constexpr size_t WGU_B = (size_t)5632 * 1024 * 2, WDN_B = (size_t)1024 * 2816 * 2, FFN_STRIDE = WGU_B + WDN_B;
constexpr size_t OFF_FFN = 0;
constexpr size_t OFF_WEIN = OFF_FFN + 4 * FFN_STRIDE;
constexpr size_t OFF_WEOUT = OFF_WEIN + al256((size_t)2816 * 1024 * 2);
constexpr size_t OFF_WUQ = OFF_WEOUT + al256((size_t)1024 * 1024 * 2);
constexpr size_t OFF_WUKV = OFF_WUQ + al256((size_t)768 * 384 * 2);
constexpr size_t OFF_WOIN = OFF_WUKV + al256((size_t)1024 * 256 * 2);
constexpr size_t OFF_WOOUT = OFF_WOIN + al256((size_t)2048 * 1024 * 2);
constexpr size_t OFF_WLRU = OFF_WOOUT + al256((size_t)1024 * 1024 * 2);
constexpr size_t WLRU_B = (size_t)2048 * 128 * 2;
constexpr size_t OFF_H = OFF_WLRU + 2 * WLRU_B;
constexpr size_t OFF_ACT = OFF_H + al256((size_t)NTOK * 1024 * 2);
constexpr size_t OFF_R = OFF_ACT + al256((size_t)NTOK * 2816 * 2);
constexpr size_t OFF_CTXRES = OFF_R + al256((size_t)NCHAIN * NCHUNK * 16384 * 2);
constexpr size_t OFF_MOD = OFF_CTXRES + al256((size_t)2 * CTX * D * 4);
constexpr size_t OFF_G = OFF_MOD + al256((size_t)2 * 3 * NMOD * 4);
constexpr size_t OFF_RS = OFF_G + al256((size_t)NTOK * 16 * 4);
constexpr size_t OFF_KR = OFF_RS + al256((size_t)NTOK * 2 * 4);
constexpr size_t OFF_DN = OFF_KR + al256((size_t)NTOK * 32 * 2);
constexpr size_t OFF_NST = OFF_DN + al256((size_t)NCHAIN * NCHUNK * 128 * 4);
constexpr size_t OFF_MLOC = OFF_NST + al256((size_t)NCHAIN * NCHUNK * 128 * 4);
constexpr size_t OFF_BEND = OFF_MLOC + al256((size_t)NCHAIN * NCHUNK * 4);
constexpr size_t OFF_MST = OFF_BEND + al256((size_t)NCHAIN * NCHUNK * 4);
constexpr size_t OFF_BAR = OFF_MST + al256((size_t)NCHAIN * NCHUNK * 4);
constexpr size_t OFF_KMAX = OFF_BAR + al256((size_t)3456 * 4);
constexpr size_t OFF_ROPE = OFF_KMAX + 256;
constexpr size_t OFF_SUMA = OFF_ROPE + 128 * 8 * 8;
constexpr size_t OFF_SUMH = OFF_SUMA + al256((size_t)8 * 264 * 256 * 4);
constexpr size_t WS_TOTAL = OFF_SUMH + al256((size_t)8 * 264 * 256 * 4);

struct Params {
  const float *x, *c, *ctx, *c_ctx, *mod_w, *mod_b, *norm_g, *ffn_w_gate, *ffn_w_up, *ffn_w_down;
  const float *even_w_in, *even_w_out, *mla_cq_g, *mla_w_uq, *mla_ckv_g, *mla_w_ukv, *mla_q_g, *mla_k_g;
  const float *mlstm_gate_b, *mlstm_out_g, *odd_w_in, *odd_conv_w, *odd_conv_b;
  const float *lru_w_a, *lru_b_a, *lru_w_x, *lru_b_x, *lru_lam, *odd_w_out;
  float* out;
  char* ws;
  __host__ __device__ __forceinline__ char* wsl() const {
#if defined(__HIP_DEVICE_COMPILE__)
    return (char*)((__attribute__((address_space(1))) char*)ws);
#else
    return ws;
#endif
  }
  __host__ __device__ __forceinline__ float* ctxres() const { return (float*)(wsl() + OFF_CTXRES); }
  __host__ __device__ __forceinline__ float* mod() const { return (float*)(wsl() + OFF_MOD); }
  __host__ __device__ __forceinline__ float* G() const { return (float*)(wsl() + OFF_G); }
  __host__ __device__ __forceinline__ float* RS() const { return (float*)(wsl() + OFF_RS); }
  __host__ __device__ __forceinline__ bf16_t* KR() const { return (bf16_t*)(wsl() + OFF_KR); }
  __host__ __device__ __forceinline__ float* dn() const { return (float*)(wsl() + OFF_DN); }
  __host__ __device__ __forceinline__ float* nst() const { return (float*)(wsl() + OFF_NST); }
  __host__ __device__ __forceinline__ float* mloc() const { return (float*)(wsl() + OFF_MLOC); }
  __host__ __device__ __forceinline__ float* bend() const { return (float*)(wsl() + OFF_BEND); }
  __host__ __device__ __forceinline__ float* mst() const { return (float*)(wsl() + OFF_MST); }
  __host__ __device__ __forceinline__ bf16_t* Wgu(int i) const { return (bf16_t*)(wsl() + OFF_FFN + (size_t)i * FFN_STRIDE); }
  __host__ __device__ __forceinline__ bf16_t* Wd(int i) const { return (bf16_t*)(wsl() + OFF_FFN + (size_t)i * FFN_STRIDE + WGU_B); }
  __host__ __device__ __forceinline__ bf16_t* Wein() const { return (bf16_t*)(wsl() + OFF_WEIN); }
  __host__ __device__ __forceinline__ bf16_t* Weout() const { return (bf16_t*)(wsl() + OFF_WEOUT); }
  __host__ __device__ __forceinline__ bf16_t* Wuq() const { return (bf16_t*)(wsl() + OFF_WUQ); }
  __host__ __device__ __forceinline__ bf16_t* Wukv() const { return (bf16_t*)(wsl() + OFF_WUKV); }
  __host__ __device__ __forceinline__ bf16_t* Woin() const { return (bf16_t*)(wsl() + OFF_WOIN); }
  __host__ __device__ __forceinline__ bf16_t* Woout() const { return (bf16_t*)(wsl() + OFF_WOOUT); }
  __host__ __device__ __forceinline__ bf16_t* Wlru(int i) const { return (bf16_t*)(wsl() + OFF_WLRU + (size_t)i * WLRU_B); }
  __host__ __device__ __forceinline__ bf16_t* H() const { return (bf16_t*)(wsl() + OFF_H); }
  __host__ __device__ __forceinline__ bf16_t* ACT() const { return (bf16_t*)(wsl() + OFF_ACT); }
  __host__ __device__ __forceinline__ bf16_t* R() const { return (bf16_t*)(wsl() + OFF_R); }
  __host__ __device__ __forceinline__ bf16_t* XC() const { return (bf16_t*)(wsl() + OFF_FFN); }
  __host__ __device__ __forceinline__ unsigned* bar() const { return (unsigned*)(wsl() + OFF_BAR); }
  __host__ __device__ __forceinline__ float* SUMA() const { return (float*)(wsl() + OFF_SUMA); }
  __host__ __device__ __forceinline__ float* SUMH() const { return (float*)(wsl() + OFF_SUMH); }
  __host__ __device__ __forceinline__ float2* ropetab() const { return (float2*)(wsl() + OFF_ROPE); }
  __host__ __device__ __forceinline__ unsigned* kmax2() const { return (unsigned*)(wsl() + OFF_KMAX); }
};

__device__ __forceinline__ float bf2f(bf16_t h) { return __uint_as_float(((uint32_t)h) << 16); }
__device__ __forceinline__ bf16_t f2bf(float f) {
  uint32_t u = __float_as_uint(f);
  u += 0x7FFFu + ((u >> 16) & 1u);
  return (bf16_t)(u >> 16);
}
__device__ __forceinline__ uint32_t pack2(float a, float b) { uint32_t r; asm("v_cvt_pk_bf16_f32 %0, %1, %2" : "=v"(r) : "v"(a), "v"(b)); return r; }
__device__ __forceinline__ float lo2f(uint32_t u) { return __uint_as_float(u << 16); }
__device__ __forceinline__ float hi2f(uint32_t u) { return __uint_as_float(u & 0xFFFF0000u); }
__device__ __forceinline__ float sigmoidf_(float x) { return __builtin_amdgcn_rcpf(1.0f + __expf(-x)); }
__device__ __forceinline__ float siluf_(float x) { return x * __builtin_amdgcn_rcpf(1.0f + __expf(-x)); }
__device__ __forceinline__ float logsigmoidf_(float x) { return fminf(x, 0.0f) - log1pf(__expf(-fabsf(x))); }
__device__ __forceinline__ float gelu_tanh(float x) {
  float z = 0.7978845608028654f * (x + 0.044715f * x * x * x);
  float t = 1.0f - 2.0f / (1.0f + __expf(2.0f * z));
  return 0.5f * x * (1.0f + t);
}
__device__ __forceinline__ float* xrow(const Params& p, int r) {
  int b = r >= TPB ? 1 : 0; int u = r - b * TPB;
  return (u < CTX) ? p.ctxres() + (size_t)(b * CTX + u) * D : p.out + ((size_t)b * SEQ + (u - CTX)) * D;
}
__device__ __forceinline__ int condof(int r) { int b = r >= TPB ? 1 : 0; int u = r - b * TPB; return u < CTX ? 2 : b; }
__device__ __forceinline__ float wave_sum(float v) {
#pragma unroll
  for (int o = 32; o >= 1; o >>= 1) v += __shfl_xor(v, o);
  return v;
}
__device__ __forceinline__ float wave_max(float v) {
#pragma unroll
  for (int o = 32; o >= 1; o >>= 1) v = fmaxf(v, __shfl_xor(v, o));
  return v;
}
__device__ __forceinline__ int otid() { int t = threadIdx.x; asm volatile("" : "+v"(t)); return t; }
__device__ __forceinline__ int obid() { int t = blockIdx.x; asm volatile("" : "+s"(t)); return t; }
__device__ const float ROPE_INV[8] = {1.0f, 0.316227766016838f, 0.1f, 0.0316227766016838f, 0.01f, 0.00316227766016838f, 0.001f, 0.000316227766016838f};
#define MFMA16(a, b, c) __builtin_amdgcn_mfma_f32_16x16x32_bf16(a, b, c, 0, 0, 0)


__device__ __forceinline__ WDesc get_wdesc(const Params& p, int wi) {
  WDesc d; d.kscale = nullptr; d.nb = 1; d.pad = 0;
  if (wi < 4224) {
    int di = wi / 352, lf = di / 3, kind = di - lf * 3;
    d.item_start = di * 352;
    if (kind == 0) { d.src = p.ffn_w_gate + (size_t)lf * 1024 * 2816; d.dst = p.Wgu(lf); d.K = 1024; d.N = 2816; d.ntn = 44; d.nkt = 8; d.mode = 1; }
    else if (kind == 1) { d.src = p.ffn_w_up + (size_t)lf * 1024 * 2816; d.dst = p.Wgu(lf); d.K = 1024; d.N = 2816; d.ntn = 44; d.nkt = 8; d.mode = 2; }
    else { d.src = p.ffn_w_down + (size_t)lf * 2816 * 1024; d.dst = p.Wd(lf); d.K = 2816; d.N = 1024; d.ntn = 16; d.nkt = 22; d.mode = 0; }
  } else if (wi < 4576) { d.src = p.even_w_in; d.dst = p.Wein(); d.K = 1024; d.N = 2736; d.ntn = 44; d.nkt = 8; d.mode = 0; d.item_start = 4224; }
  else if (wi < 4704) { d.src = p.even_w_out; d.dst = p.Weout(); d.K = 1024; d.N = 1024; d.ntn = 16; d.nkt = 8; d.mode = 0; d.item_start = 4576; }
  else if (wi < 4740) { d.src = p.mla_w_uq; d.dst = p.Wuq(); d.kscale = p.mla_cq_g; d.K = 384; d.N = 768; d.ntn = 12; d.nkt = 3; d.mode = 0; d.item_start = 4704; }
  else if (wi < 4772) { d.src = p.mla_w_ukv; d.dst = p.Wukv(); d.kscale = p.mla_ckv_g; d.K = 256; d.N = 1024; d.ntn = 16; d.nkt = 2; d.mode = 0; d.item_start = 4740; }
  else if (wi < 5028) { d.src = p.odd_w_in; d.dst = p.Woin(); d.K = 1024; d.N = 2048; d.ntn = 32; d.nkt = 8; d.mode = 0; d.item_start = 4772; }
  else if (wi < 5156) { d.src = p.odd_w_out; d.dst = p.Woout(); d.K = 1024; d.N = 1024; d.ntn = 16; d.nkt = 8; d.mode = 0; d.item_start = 5028; }
  else {
    int q = (wi - 5156) >> 4, dir = q >> 1, gx = q & 1;
    d.src = (gx ? p.lru_w_x : p.lru_w_a) + (size_t)dir * 8 * 128 * 128; d.dst = p.Wlru(dir);
    d.K = 128; d.N = 128; d.ntn = 2; d.nkt = 1; d.nb = 8; d.mode = 1 + gx; d.item_start = 5156 + q * 16;
  }
  return d;
}

__device__ __forceinline__ void wload(const WDesc& d, int wi, int tid, float4 (&v)[4]) {
  int local = wi - d.item_start;
  int tiles = d.ntn * d.nkt;
  int bi = local / tiles, rem = local - bi * tiles;
  int kt = rem / d.ntn, nt = rem - kt * d.ntn;
  const float* src = d.src + (size_t)bi * d.K * d.N;
  int k0 = kt * 128, n0 = nt * 64;
#pragma unroll
  for (int i = 0; i < 4; ++i) {
    int idx = tid + i * NTHR;
    int k = idx >> 4, n4 = (idx & 15) * 4;
    v[i] = make_float4(0, 0, 0, 0);
    if (n0 + n4 < d.N) v[i] = *(const float4*)(src + (size_t)(k0 + k) * d.N + n0 + n4);
    if (d.kscale) { float g = d.kscale[k0 + k]; v[i].x *= g; v[i].y *= g; v[i].z *= g; v[i].w *= g; }
  }
}
__device__ __forceinline__ int wsw(int n, int k) { return n * 136 + ((((k >> 3) ^ (n >> 2)) & 15) << 3) + (k & 7); }
__device__ __forceinline__ void wstore(const WDesc& d, int wi, int tid, const float4 (&v)[4], bf16_t* s) {
  int local = wi - d.item_start;
  int tiles = d.ntn * d.nkt;
  int bi = local / tiles, rem = local - bi * tiles;
  int kt = rem / d.ntn, nt = rem - kt * d.ntn;
  int k0 = kt * 128, n0 = nt * 64;
#pragma unroll
  for (int i = 0; i < 4; ++i) {
    int idx = tid + i * NTHR;
    int k = idx >> 4, n4 = (idx & 15) * 4;
    s[wsw(n4 + 0, k)] = f2bf(v[i].x);
    s[wsw(n4 + 1, k)] = f2bf(v[i].y);
    s[wsw(n4 + 2, k)] = f2bf(v[i].z);
    s[wsw(n4 + 3, k)] = f2bf(v[i].w);
  }
  __syncthreads();
#pragma unroll
  for (int i = 0; i < 2; ++i) {
    int idx = tid + i * NTHR;
    int n = idx >> 4, kc = (idx & 15) * 8;
    int gidx = bi * d.N + n0 + n;
    int drow = gidx;
    if (d.mode != 0) drow = (gidx >> 6) * 128 + ((gidx & 63) >> 4) * 32 + (gidx & 15) + (d.mode == 2 ? 16 : 0);
    uint4 o = *(const uint4*)(s + wsw(n, kc));
    *(uint4*)(d.dst + (size_t)drow * d.K + k0 + kc) = o;
  }
  __syncthreads();
}

__device__ __forceinline__ void p0_phase(const Params& p, char* smem) {
  const int tid = otid();
  const int G = gridDim.x, bid = obid();
  for (int it = bid; it < 144; it += G) {
    int layer = it / 72, cgp = it % 72;
    float* sc = (float*)smem;
    float* red = sc + 3 * 1024;
    for (int i = tid; i < 3 * 1024; i += NTHR) {
      int r = i >> 10, k = i & 1023;
      float v = (r < 2) ? p.c[r * 1024 + k] : p.c_ctx[k];
      sc[i] = siluf_(v);
    }
    __syncthreads();
    int ksl = tid >> 5, l32 = tid & 31;
    int col = cgp * 128 + l32 * 4;
    float a0[4] = {0, 0, 0, 0}, a1[4] = {0, 0, 0, 0}, a2[4] = {0, 0, 0, 0};
    const float* wp = p.mod_w + ((size_t)layer * 1024 + ksl * 64) * NMOD + col;
#pragma unroll 16
    for (int k = 0; k < 64; ++k) {
      float4 wv = *(const float4*)(wp + (size_t)k * NMOD);
      float s0 = sc[ksl * 64 + k], s1 = sc[1024 + ksl * 64 + k], s2 = sc[2048 + ksl * 64 + k];
      a0[0] += s0 * wv.x; a0[1] += s0 * wv.y; a0[2] += s0 * wv.z; a0[3] += s0 * wv.w;
      a1[0] += s1 * wv.x; a1[1] += s1 * wv.y; a1[2] += s1 * wv.z; a1[3] += s1 * wv.w;
      a2[0] += s2 * wv.x; a2[1] += s2 * wv.y; a2[2] += s2 * wv.z; a2[3] += s2 * wv.w;
    }
#pragma unroll
    for (int q = 0; q < 4; ++q) {
      red[(ksl * 3 + 0) * 128 + l32 * 4 + q] = a0[q];
      red[(ksl * 3 + 1) * 128 + l32 * 4 + q] = a1[q];
      red[(ksl * 3 + 2) * 128 + l32 * 4 + q] = a2[q];
    }
    __syncthreads();
    if (tid < 384) {
      int r = tid >> 7, cc = tid & 127;
      float sum = 0;
#pragma unroll
      for (int ww = 0; ww < 16; ++ww) sum += red[(ww * 3 + r) * 128 + cc];
      int gc = cgp * 128 + cc;
      p.mod()[((size_t)layer * 3 + r) * NMOD + gc] = sum + p.mod_b[layer * NMOD + gc];
    }
    __syncthreads();
  }
  {
    bf16_t* s = (bf16_t*)smem;
    int wi = (bid + G - (144 % G)) % G;
    float4 v[4], vn[4];
    WDesc d = get_wdesc(p, wi < N_WITEMS ? wi : 0);
    if (wi < N_WITEMS) wload(d, wi, tid, v);
    while (wi < N_WITEMS) {
      int win = wi + G;
      WDesc dn = get_wdesc(p, win < N_WITEMS ? win : 0);
      if (win < N_WITEMS) wload(dn, win, tid, vn);
      wstore(d, wi, tid, v, s);
#pragma unroll
      for (int i = 0; i < 4; ++i) v[i] = vn[i];
      d = dn; wi = win;
    }
  }
  for (int i = bid * NTHR + tid; i < 1024; i += G * NTHR) {
    float ang = (float)(i >> 3) * ROPE_INV[i & 7];
    p.ropetab()[i] = make_float2(cosf(ang), sinf(ang));
  }
  for (int i = bid * NTHR + tid; i < 2 * CTX * D / 4; i += G * NTHR) ((float4*)p.ctxres())[i] = ((const float4*)p.ctx)[i];
}

__device__ __forceinline__ void normmod_phase(const Params& p, int layer, int which, int first) {
  const int tid_ = otid();
  const int lane = tid_ & 63, w = tid_ >> 6;
  const float* g = p.norm_g + (layer * 3 + which) * D;
  const int stride = gridDim.x * 8;
  const float* xlat = first ? p.x : p.out;
  for (int row0 = obid() * 8 + w; row0 < NTOK; row0 += 2 * stride) {
    float4 v[2][4];
    bool ok[2];
#pragma unroll
    for (int q = 0; q < 2; ++q) {
      int row = row0 + q * stride;
      ok[q] = row < NTOK;
      if (ok[q]) {
        int b = row >= TPB ? 1 : 0, u = row - b * TPB;
        const float* x = (u < CTX) ? p.ctxres() + (size_t)(b * CTX + u) * D : xlat + ((size_t)b * SEQ + (u - CTX)) * D;
#pragma unroll
        for (int i = 0; i < 4; ++i) v[q][i] = *(const float4*)(x + i * 256 + lane * 4);
      }
    }
#pragma unroll
    for (int q = 0; q < 2; ++q) {
      if (!ok[q]) continue;
      int row = row0 + q * stride;
      const float* md = p.mod() + ((size_t)layer * 3 + condof(row)) * NMOD + which * 3 * D;
      float ss = 0;
#pragma unroll
      for (int i = 0; i < 4; ++i) ss += v[q][i].x * v[q][i].x + v[q][i].y * v[q][i].y + v[q][i].z * v[q][i].z + v[q][i].w * v[q][i].w;
      ss = wave_sum(ss);
      float rstd = rsqrtf(ss * (1.0f / D) + 1e-6f);
#pragma unroll
      for (int i = 0; i < 4; ++i) {
        int cidx = i * 256 + lane * 4;
        float4 g4 = *(const float4*)(g + cidx);
        float4 sh = *(const float4*)(md + cidx);
        float4 sc = *(const float4*)(md + D + cidx);
        float h0 = v[q][i].x * rstd * g4.x * (1.0f + sc.x) + sh.x;
        float h1 = v[q][i].y * rstd * g4.y * (1.0f + sc.y) + sh.y;
        float h2 = v[q][i].z * rstd * g4.z * (1.0f + sc.z) + sh.z;
        float h3 = v[q][i].w * rstd * g4.w * (1.0f + sc.w) + sh.w;
        uint2 o; o.x = pack2(h0, h1); o.y = pack2(h2, h3);
        *(uint2*)(p.H() + (size_t)row * D + cidx) = o;
      }
    }
  }
}

enum { EPI_SWIGLU = 1, EPI_RESID = 2, EPI_E1 = 3, EPI_ROWSCALE = 4, EPI_PLAIN = 5, EPI_LRU = 6 };
struct EpiArgs {
  bf16_t* outb; int ldo; int slot; float scale; int layer; int dir;
  float* outf; const float* rs; uint32_t* outu;
};
constexpr int LDT = 72;

template <int EPI>
__device__ __forceinline__ void gemm_tile(const Params& p, const EpiArgs& ea, const bf16_t* __restrict__ A, int lda,
                                          const bf16_t* __restrict__ Bt, int K, int m0, int n0, char* smem) {
  bf16_t* sA = (bf16_t*)smem;
  bf16_t* sB = sA + 2 * 256 * LDT;
  const int tid = otid(), lane = tid & 63, w = tid >> 6, wm = w & 3, wn = w >> 2, fr = lane & 15, fq = lane >> 4;
  f32x4 acc[4][4];
#pragma unroll
  for (int i = 0; i < 4; ++i)
#pragma unroll
    for (int j = 0; j < 4; ++j) acc[i][j] = (f32x4){0.f, 0.f, 0.f, 0.f};
  const int srow = tid >> 3, sch = (tid & 7) * 8;
  const bf16_t* ap = A + (size_t)(m0 + srow) * lda + sch;
  const bf16_t* bp = Bt + (size_t)(n0 + srow) * K + sch;
  const size_t a_step = (size_t)64 * lda, b_step = (size_t)64 * K;
  uint4 ra[4], rb[2];
  const int nk = K >> 6;
#pragma unroll
  for (int i = 0; i < 4; ++i) ra[i] = *(const uint4*)(ap + i * a_step);
#pragma unroll
  for (int i = 0; i < 2; ++i) rb[i] = *(const uint4*)(bp + i * b_step);
#pragma unroll
  for (int i = 0; i < 4; ++i) *(uint4*)(sA + (srow + i * 64) * LDT + sch) = ra[i];
#pragma unroll
  for (int i = 0; i < 2; ++i) *(uint4*)(sB + (srow + i * 64) * LDT + sch) = rb[i];
  __syncthreads();
  for (int kt = 0; kt < nk; ++kt) {
    const int buf = kt & 1;
    if (kt + 1 < nk) {
#pragma unroll
      for (int i = 0; i < 4; ++i) ra[i] = *(const uint4*)(ap + i * a_step + (kt + 1) * 64);
#pragma unroll
      for (int i = 0; i < 2; ++i) rb[i] = *(const uint4*)(bp + i * b_step + (kt + 1) * 64);
    }
    const bf16_t* cA = sA + buf * 256 * LDT + (wm * 64 + fr) * LDT + fq * 8;
    const bf16_t* cB = sB + buf * 128 * LDT + (wn * 64 + fr) * LDT + fq * 8;
#pragma unroll
    for (int ks = 0; ks < 2; ++ks) {
      bf16x8 af[4], bfg[4];
#pragma unroll
      for (int mi = 0; mi < 4; ++mi) af[mi] = *(const bf16x8*)(cA + mi * 16 * LDT + ks * 32);
#pragma unroll
      for (int ni = 0; ni < 4; ++ni) bfg[ni] = *(const bf16x8*)(cB + ni * 16 * LDT + ks * 32);
#pragma unroll
      for (int mi = 0; mi < 4; ++mi)
#pragma unroll
        for (int ni = 0; ni < 4; ++ni) acc[mi][ni] = MFMA16(af[mi], bfg[ni], acc[mi][ni]);
    }
    if (kt + 1 < nk) {
      bf16_t* dA = sA + (buf ^ 1) * 256 * LDT;
      bf16_t* dB = sB + (buf ^ 1) * 128 * LDT;
#pragma unroll
      for (int i = 0; i < 4; ++i) *(uint4*)(dA + (srow + i * 64) * LDT + sch) = ra[i];
#pragma unroll
      for (int i = 0; i < 2; ++i) *(uint4*)(dB + (srow + i * 64) * LDT + sch) = rb[i];
    }
    __syncthreads();
  }
#pragma unroll
  for (int mi = 0; mi < 4; ++mi) {
    const int r0 = m0 + wm * 64 + mi * 16 + fq * 4;
    if (EPI == EPI_SWIGLU) {
#pragma unroll
      for (int nh = 0; nh < 2; ++nh) {
        int hc = (n0 >> 1) + wn * 32 + nh * 16 + fr;
#pragma unroll
        for (int j = 0; j < 4; ++j) {
          float g = acc[mi][nh * 2][j], u = acc[mi][nh * 2 + 1][j];
          ea.outb[(size_t)(r0 + j) * ea.ldo + hc] = f2bf(siluf_(g) * u);
        }
      }
    } else if (EPI == EPI_RESID) {
      float* xb = xrow(p, r0);
      const float* md = p.mod() + ((size_t)ea.layer * 3 + condof(r0)) * NMOD + ea.slot * D;
#pragma unroll
      for (int ni = 0; ni < 4; ++ni) {
        int cc = n0 + wn * 64 + ni * 16 + fr;
        float gs = md[cc] * ea.scale;
#pragma unroll
        for (int j = 0; j < 4; ++j) {
          float* px = xb + (size_t)j * D + cc;
          *px = *px + gs * acc[mi][ni][j];
        }
      }
    } else if (EPI == EPI_E1) {
#pragma unroll
      for (int ni = 0; ni < 4; ++ni) {
        int cc = n0 + wn * 64 + ni * 16 + fr;
        float sc = (cc >= 1184 && cc < 1696) ? 0.08838834764831845f : 1.0f;
#pragma unroll
        for (int j = 0; j < 4; ++j) {
          float v = acc[mi][ni][j];
          ea.outb[(size_t)(r0 + j) * PW + cc] = f2bf(v * sc);
          if (cc >= 2720 && cc < 2736) ea.outf[(size_t)(r0 + j) * 16 + (cc - 2720)] = v;
        }
      }
    } else if (EPI == EPI_ROWSCALE) {
#pragma unroll
      for (int j = 0; j < 4; ++j) {
        float rs = ea.rs[(size_t)(r0 + j) * 2];
#pragma unroll
        for (int ni = 0; ni < 4; ++ni) {
          int cc = n0 + wn * 64 + ni * 16 + fr;
          ea.outb[(size_t)(r0 + j) * ea.ldo + cc] = f2bf(acc[mi][ni][j] * rs);
        }
      }
    } else if (EPI == EPI_PLAIN) {
#pragma unroll
      for (int ni = 0; ni < 4; ++ni) {
        int cc = n0 + wn * 64 + ni * 16 + fr;
#pragma unroll
        for (int j = 0; j < 4; ++j) ea.outb[(size_t)(r0 + j) * ea.ldo + cc] = f2bf(acc[mi][ni][j]);
      }
    } else if (EPI == EPI_LRU) {
#pragma unroll
      for (int nh = 0; nh < 2; ++nh) {
        int ch = (n0 >> 1) + wn * 32 + nh * 16 + fr;
        float ba = p.lru_b_a[ea.dir * 1024 + ch], bx = p.lru_b_x[ea.dir * 1024 + ch];
        float sp8 = -8.0f * log1pf(__expf(-p.lru_lam[ea.dir * 1024 + ch]));
#pragma unroll
        for (int j = 0; j < 4; ++j) {
          float r = sigmoidf_(acc[mi][nh * 2][j] + ba);
          float ig = sigmoidf_(acc[mi][nh * 2 + 1][j] + bx);
          float la = r * sp8;
          float x2 = 2.0f * la;
          float poly = -x2 * (1.0f + x2 * (0.5f + x2 * (0.16666667f + x2 * (0.041666668f + x2 * (0.008333334f + x2 * 0.0013888889f)))));
          float em = (x2 < -0.3f) ? (1.0f - __expf(x2)) : poly;
          float u = bf2f(p.XC()[(size_t)(r0 + j) * D + ch]);
          float inp = __builtin_amdgcn_sqrtf(fmaxf(em, 0.0f)) * (ig * u);
          ea.outu[(size_t)(r0 + j) * D + ch] = pack2(la, inp);
        }
      }
    }
  }
}

namespace pg8 {
#define PG8_LAS __attribute__((address_space(3)))
typedef unsigned u32x4 __attribute__((ext_vector_type(4)));
constexpr int BM = 256, BK = 64, HALF = 128, HTB = HALF * BK * 2, STAGE_BYTES = 8 * HTB, NXCD = 8, WGM = 8;
__device__ __forceinline__ int lds_byte(int r, int c) { const int st = (r >> 4) * 2 + (c >> 5), rr = r & 15, cc = c & 31, ob = rr * 64 + cc * 2; return st * 1024 + (ob ^ (((ob >> 9) & 1) << 5)); }
__device__ __forceinline__ void stage_rc(int b, int& R, int& C) { const int st = b / 1024, sb = b % 1024, swz = sb ^ (((sb >> 9) & 1) << 5); R = (st >> 1) * 16 + swz / 64; C = (st & 1) * 32 + (swz % 64) / 2; }
struct Unit { int pm, pn; };
struct Gemm { const bf16_t* A; int lda; const bf16_t* Bt; int K; };
struct Sched {
  int nM, nN, nwg, G, c, latent;
  __device__ void init(int nM_, int nN_, int G_, int c_, int latent_) { nM = nM_; nN = nN_; nwg = nM * nN; G = G_; c = c_; latent = latent_; }
  __device__ bool next(int i, Unit& u) const {
    const long L = (long)i * G + c; if (L >= nwg) return false;
    int wgid = (int)L; { const int q = nwg / NXCD, r = nwg % NXCD, xcd = wgid % NXCD, off = wgid / NXCD; wgid = (xcd < r ? xcd * (q + 1) : r * (q + 1) + (xcd - r) * q) + off; }
    const int nig = WGM * nN, gid = wgid / nig, fm = gid * WGM, gsz = (nM - fm) < WGM ? (nM - fm) : WGM;
    int pm = fm + ((wgid % nig) % gsz); u.pn = (wgid % nig) / gsz;
    if (latent) pm = pm + 1 + (pm >= 32 ? 1 : 0);
    u.pm = pm; return true;
  }
};
template <class Epi>
__device__ __forceinline__ void gemm_phase(PG8_LAS unsigned char* lds, const Gemm g, const Sched& S, const Epi& E) {
    const int tid = otid(), wid = __builtin_amdgcn_readfirstlane(tid >> 6), lane = tid & 63, wr = wid >> 2, wc = wid & 3, fr = lane & 15, fq = lane >> 4;
    const int K = g.K, nt = K / BK, lda = g.lda;
    unsigned voffA[2], voffB[2];
#pragma unroll
    for (int i = 0; i < 2; ++i) { int R, C; stage_rc(tid * 16 + i * 8192, R, C);
        voffA[i] = (unsigned)(R * lda + C) * 2u; voffB[i] = (unsigned)(R * K + C) * 2u; }
    const size_t kstep = (size_t)(BK * 2);
    const size_t hsA = (size_t)HALF * lda * 2, hsB = (size_t)HALF * K * 2;
    const size_t tsA = 2 * hsA, tsB = 2 * hsB;
    const unsigned ldsw = (unsigned)wid * 1024u;
    const int aoff = lds_byte(wr * 64 + fr, fq * 8), boff = lds_byte(wc * 32 + fr, fq * 8);
#define PG8_SA(b, h) (((b) * 2 + (h)) * HTB)
#define PG8_SB(b, h) ((4 + (b) * 2 + (h)) * HTB)
#define PG8_STAGE(bufoff, gbase, voff) do { _Pragma("unroll") for (int _i = 0; _i < 2; ++_i) \
        __builtin_amdgcn_global_load_lds((const unsigned*)((const char*)(gbase) + (voff)[_i]), (PG8_LAS unsigned*)(lds + (bufoff) + ldsw + _i * 8192), 16, 0, 0); } while (0)
#define PG8_LDA(dst, b, h) do { _Pragma("unroll") for (int m = 0; m < 4; ++m) _Pragma("unroll") for (int k = 0; k < 2; ++k) dst[m][k] = *(const PG8_LAS bf16x8*)(lds + PG8_SA(b, h) + aoff + m * 2048 + k * 1024); } while (0)
#define PG8_LDB(dst, b, h) do { _Pragma("unroll") for (int n = 0; n < 2; ++n) _Pragma("unroll") for (int k = 0; k < 2; ++k) dst[n][k] = *(const PG8_LAS bf16x8*)(lds + PG8_SB(b, h) + boff + n * 2048 + k * 1024); } while (0)
#define PG8_MMA(ai, bj, At, Bt) do { __builtin_amdgcn_s_setprio(1); _Pragma("unroll") for (int m = 0; m < 4; ++m) _Pragma("unroll") for (int n = 0; n < 2; ++n) _Pragma("unroll") for (int k = 0; k < 2; ++k) \
        acc[ai][bj][m][n] = __builtin_amdgcn_mfma_f32_16x16x32_bf16(Bt[n][k], At[m][k], acc[ai][bj][m][n], 0, 0, 0); __builtin_amdgcn_s_setprio(0); } while (0)
#define PG8_WAIT_V(n) asm volatile("s_waitcnt vmcnt(" #n ")" ::: "memory")
#define PG8_WAIT_L(n) asm volatile("s_waitcnt lgkmcnt(" #n ")" ::: "memory")
#define PG8_BAR __builtin_amdgcn_s_barrier()
#define PG8_SCHED __builtin_amdgcn_sched_barrier(0)
    Unit cur, nxt; int ui = 0;
    if (!S.next(0, cur)) return;
    f32x4 acc[2][2][4][2];
#pragma unroll
    for (int a = 0; a < 2; ++a)
#pragma unroll
        for (int b = 0; b < 2; ++b)
#pragma unroll
            for (int m = 0; m < 4; ++m)
#pragma unroll
                for (int n = 0; n < 2; ++n) acc[a][b][m][n] = (f32x4){0.f, 0.f, 0.f, 0.f};
    bf16x8 At[4][2], B0[2][2], B1[2][2];
    const char* cA = (const char*)g.A + (size_t)cur.pm * tsA; const char* cB = (const char*)g.Bt + (size_t)cur.pn * tsB;
    PG8_STAGE(PG8_SB(0, 0), cB, voffB); PG8_STAGE(PG8_SA(0, 0), cA, voffA); PG8_STAGE(PG8_SB(0, 1), cB + hsB, voffB); PG8_STAGE(PG8_SA(0, 1), cA + hsA, voffA);
    if (wr == 1) PG8_BAR;
    PG8_WAIT_V(4); PG8_BAR;
    PG8_STAGE(PG8_SB(1, 0), cB + kstep, voffB); PG8_STAGE(PG8_SA(1, 0), cA + kstep, voffA); PG8_STAGE(PG8_SB(1, 1), cB + hsB + kstep, voffB);
    PG8_WAIT_V(6); PG8_BAR;
    for (;;) {
        const bool has_next = S.next(ui + 1, nxt);
        const char* nA = has_next ? (const char*)g.A + (size_t)nxt.pm * tsA : cA; const char* nB = has_next ? (const char*)g.Bt + (size_t)nxt.pn * tsB : cB;
        for (int t = 0; t < nt; t += 2) {
            const bool last = (t == nt - 2);
            const char* a1 = cA + (size_t)(t + 1) * kstep;
            const char* a2 = last ? nA : cA + (size_t)(t + 2) * kstep; const char* b2 = last ? nB : cB + (size_t)(t + 2) * kstep;
            const char* a3 = a2 + kstep; const char* b3 = b2 + kstep;
            PG8_LDB(B0, 0, 0); PG8_SCHED; PG8_LDA(At, 0, 0); PG8_STAGE(PG8_SA(1, 1), a1 + hsA, voffA);
            PG8_WAIT_L(8); PG8_BAR; PG8_WAIT_L(0); PG8_MMA(0, 0, At, B0); PG8_BAR; PG8_SCHED;
            PG8_LDB(B1, 0, 1); PG8_STAGE(PG8_SB(0, 0), b2, voffB);
            PG8_BAR; PG8_WAIT_L(0); PG8_MMA(0, 1, At, B1); PG8_BAR;
            PG8_LDA(At, 0, 1); PG8_STAGE(PG8_SA(0, 0), a2, voffA);
            PG8_BAR; PG8_WAIT_L(0); PG8_MMA(1, 0, At, B0); PG8_BAR; PG8_SCHED;
            PG8_STAGE(PG8_SB(0, 1), b2 + hsB, voffB);
            PG8_WAIT_V(6); PG8_BAR; PG8_MMA(1, 1, At, B1); PG8_BAR;
            PG8_LDB(B0, 1, 0); PG8_SCHED; PG8_LDA(At, 1, 0); PG8_STAGE(PG8_SA(0, 1), a2 + hsA, voffA);
            PG8_WAIT_L(8); PG8_BAR; PG8_WAIT_L(0); PG8_MMA(0, 0, At, B0); PG8_BAR; PG8_SCHED;
            PG8_LDB(B1, 1, 1); PG8_STAGE(PG8_SB(1, 0), b3, voffB);
            PG8_BAR; PG8_WAIT_L(0); PG8_MMA(0, 1, At, B1); PG8_BAR;
            PG8_LDA(At, 1, 1); PG8_STAGE(PG8_SA(1, 0), a3, voffA);
            PG8_BAR; PG8_WAIT_L(0); PG8_MMA(1, 0, At, B0); PG8_BAR; PG8_SCHED;
            PG8_STAGE(PG8_SB(1, 1), b3 + hsB, voffB);
            PG8_WAIT_V(6); PG8_BAR; PG8_MMA(1, 1, At, B1); PG8_BAR;
        }
        E(acc, cur, wr, wc, fr, fq);
        if (!has_next) break;
#pragma unroll
        for (int a = 0; a < 2; ++a)
#pragma unroll
            for (int b = 0; b < 2; ++b)
#pragma unroll
                for (int m = 0; m < 4; ++m)
#pragma unroll
                    for (int n = 0; n < 2; ++n) acc[a][b][m][n] = (f32x4){0.f, 0.f, 0.f, 0.f};
        cur = nxt; cA = nA; cB = nB; ++ui;
    }
    PG8_WAIT_V(0);
    if (wr == 0) PG8_BAR;
    PG8_BAR;
#undef PG8_SA
#undef PG8_SB
#undef PG8_STAGE
#undef PG8_LDA
#undef PG8_LDB
#undef PG8_MMA
#undef PG8_WAIT_V
#undef PG8_WAIT_L
#undef PG8_BAR
#undef PG8_SCHED
}
}

struct FEpi {
  int kind; float* xout; float* xctx; const float* xin; const float* modp; bf16_t* outb; int ldo; int slot; float scale; int layer; float* outf; const float* rs;
  __device__ __forceinline__ void operator()(const f32x4 (&acc)[2][2][4][2], const pg8::Unit& u, int wr, int wc, int fr, int fq) const {
    float4 gsv[2][2];
    if (kind == EPI_RESID) {
      const float* md0 = modp + ((size_t)layer * 3 + condof(u.pm * 256)) * NMOD + slot * D;
#pragma unroll
      for (int bj = 0; bj < 2; ++bj)
#pragma unroll
        for (int n = 0; n < 2; ++n) {
          float4 t = *(const float4*)(md0 + u.pn * 256 + bj * 128 + wc * 32 + n * 16 + fq * 4);
          gsv[bj][n] = make_float4(t.x * scale, t.y * scale, t.z * scale, t.w * scale);
        }
    }
#pragma unroll
    for (int ai = 0; ai < 2; ++ai)
#pragma unroll
      for (int m = 0; m < 4; ++m) {
        const int row = u.pm * 256 + ai * 128 + wr * 64 + m * 16 + fr;
        if (kind == EPI_SWIGLU) {
#pragma unroll
          for (int bj = 0; bj < 2; ++bj) {
            int hc = u.pn * 128 + bj * 64 + wc * 16 + fq * 4;
            f32x4 g = acc[ai][bj][m][0], up = acc[ai][bj][m][1];
            uint2 o; o.x = pack2(siluf_(g[0]) * up[0], siluf_(g[1]) * up[1]); o.y = pack2(siluf_(g[2]) * up[2], siluf_(g[3]) * up[3]);
            *(uint2*)(outb + (size_t)row * ldo + hc) = o;
          }
        } else if (kind == EPI_RESID) {
          float* xb;
          { int b_ = row >= TPB ? 1 : 0; int u_ = row - b_ * TPB;
            xb = (u_ < CTX) ? xctx + (size_t)(b_ * CTX + u_) * D : xout + ((size_t)b_ * SEQ + (u_ - CTX)) * D; }
          const float* xr = (xb >= xout && xb < xout + (size_t)2 * SEQ * D) ? xin + (xb - xout) : xb;
#pragma unroll
          for (int bj = 0; bj < 2; ++bj)
#pragma unroll
            for (int n = 0; n < 2; ++n) {
              int cc = u.pn * 256 + bj * 128 + wc * 32 + n * 16 + fq * 4;
              const float4 gs = gsv[bj][n];
              float4 xv = *(const float4*)(xr + cc);
              f32x4 a = acc[ai][bj][m][n];
              xv.x += gs.x * a[0]; xv.y += gs.y * a[1]; xv.z += gs.z * a[2]; xv.w += gs.w * a[3];
              *(float4*)(xb + cc) = xv;
            }
        } else if (kind == EPI_E1) {
#pragma unroll
          for (int bj = 0; bj < 2; ++bj)
#pragma unroll
            for (int n = 0; n < 2; ++n) {
              int cc = u.pn * 256 + bj * 128 + wc * 32 + n * 16 + fq * 4;
              float sc = (cc >= 1184 && cc < 1696) ? 0.08838834764831845f : 1.0f;
              f32x4 a = acc[ai][bj][m][n];
              uint2 o; o.x = pack2(a[0] * sc, a[1] * sc); o.y = pack2(a[2] * sc, a[3] * sc);
              *(uint2*)(outb + (size_t)row * PW + cc) = o;
              if (cc >= 2720 && cc < 2736) *(float4*)(outf + (size_t)row * 16 + (cc - 2720)) = make_float4(a[0], a[1], a[2], a[3]);
            }
        } else {
          float rsv = (kind == EPI_ROWSCALE) ? rs[(size_t)row * 2] : 1.0f;
#pragma unroll
          for (int bj = 0; bj < 2; ++bj)
#pragma unroll
            for (int n = 0; n < 2; ++n) {
              int cc = u.pn * 256 + bj * 128 + wc * 32 + n * 16 + fq * 4;
              f32x4 a = acc[ai][bj][m][n];
              uint2 o; o.x = pack2(a[0] * rsv, a[1] * rsv); o.y = pack2(a[2] * rsv, a[3] * rsv);
              *(uint2*)(outb + (size_t)row * ldo + cc) = o;
            }
        }
      }
  }
};

template <int KIND>
struct FEpiK : FEpi {
  __device__ __forceinline__ void operator()(const f32x4 (&acc)[2][2][4][2], const pg8::Unit& u, int wr, int wc, int fr, int fq) const {
    FEpi e = *this; e.kind = KIND; e(acc, u, wr, wc, fr, fq);
  }
};

template <int KIND>
__device__ __forceinline__ void fast_gemm(const Params& p, FEpi e, const bf16_t* A, int lda, const bf16_t* Bt, int K, int nN, int latent, char* smem) {
  pg8::Sched S; S.init(latent ? 64 : 66, nN, gridDim.x, obid(), latent);
  pg8::Gemm g{A, lda, Bt, K};
  FEpiK<KIND> ek; *(FEpi*)&ek = e; ek.xout = p.out; ek.xctx = p.ctxres(); ek.modp = p.mod(); ek.xin = e.xin ? e.xin : p.out;
  pg8::gemm_phase(( __attribute__((address_space(3))) unsigned char*)smem, g, S, ek);
}

template <int KIND>
__device__ __forceinline__ void ctx_gemm(const Params& p, const FEpi& e, const bf16_t* A, int lda, const bf16_t* Bt, int K, int col0, int ncg, char* smem) {
  const int tid = otid(), lane = tid & 63, w = tid >> 6, fr = lane & 15, fq = lane >> 4;
  bf16_t* sA = (bf16_t*)smem;
  bf16_t* sB = sA + 2 * 32 * 136;
  const int mr = w & 1, nc = w >> 1;
  for (int it = obid(); it < 16 * ncg; it += gridDim.x) {
    const int rg = it & 15, cgp = it >> 4;
    const int cr0 = rg * 32;
    const int rowb = (cr0 >> 8) * TPB + (cr0 & 255);
    const int cb = col0 + cgp * 64;
    const int r0 = tid >> 4, ch = (tid & 15) * 8;
    const bf16_t* g0 = A + (size_t)(rowb + r0) * lda + ch;
    const bf16_t* g1 = Bt + (size_t)(cb + r0) * K + ch;
    const bf16_t* g2 = Bt + (size_t)(cb + 32 + r0) * K + ch;
    const int l0 = r0 * 136 + ch;
    uint4 v0 = *(const uint4*)g0, v1 = *(const uint4*)g1, v2 = *(const uint4*)g2;
    *(uint4*)(sA + l0) = v0; *(uint4*)(sB + l0) = v1; *(uint4*)(sB + 32 * 136 + l0) = v2;
    __syncthreads();
    f32x4 acc = (f32x4){0.f, 0.f, 0.f, 0.f};
    const int nk = K >> 7;
    for (int kt = 0; kt < nk; ++kt) {
      const int buf = kt & 1;
      if (kt + 1 < nk) { v0 = *(const uint4*)(g0 + (kt + 1) * 128); v1 = *(const uint4*)(g1 + (kt + 1) * 128); v2 = *(const uint4*)(g2 + (kt + 1) * 128); }
      const bf16_t* cA = sA + buf * 32 * 136 + (mr * 16 + fr) * 136 + fq * 8;
      const bf16_t* cB = sB + buf * 64 * 136 + (nc * 16 + fr) * 136 + fq * 8;
#pragma unroll
      for (int ks = 0; ks < 4; ++ks) {
        bf16x8 a = *(const bf16x8*)(cA + ks * 32);
        bf16x8 b = *(const bf16x8*)(cB + ks * 32);
        acc = MFMA16(b, a, acc);
        asm volatile("" :: "v"(a), "v"(b));
      }
      if (kt + 1 < nk) {
        bf16_t* dA = sA + (buf ^ 1) * 32 * 136; bf16_t* dB = sB + (buf ^ 1) * 64 * 136;
        *(uint4*)(dA + l0) = v0; *(uint4*)(dB + l0) = v1; *(uint4*)(dB + 32 * 136 + l0) = v2;
      }
      __syncthreads();
    }
    const int row = rowb + mr * 16 + fr, cc = cb + nc * 16 + fq * 4;
    if (KIND == EPI_RESID) {
      float* xb = xrow(p, row);
      const float* md = p.mod() + ((size_t)e.layer * 3 + 2) * NMOD + e.slot * D;
      float4 gs = *(const float4*)(md + cc);
      float4 xv = *(float4*)(xb + cc);
      xv.x += e.scale * gs.x * acc[0]; xv.y += e.scale * gs.y * acc[1]; xv.z += e.scale * gs.z * acc[2]; xv.w += e.scale * gs.w * acc[3];
      *(float4*)(xb + cc) = xv;
    } else {
      uint2 o; o.x = pack2(acc[0], acc[1]); o.y = pack2(acc[2], acc[3]);
      *(uint2*)(e.outb + (size_t)row * e.ldo + cc) = o;
    }
  }
}

template <int EPI>
__device__ __forceinline__ void gemm_phase(const Params& p, const EpiArgs& ea, const bf16_t* A, int lda, const bf16_t* Bt, int K,
                           int Mtiles, int Ntiles, int a_mode, int rot, char* smem) {
  const int G = gridDim.x;
  const int ntiles = Mtiles * Ntiles;
  int vb = obid() - (rot % G); if (vb < 0) vb += G;
  const int nxcd = 8;
  const int per = G / nxcd;
  const int x = vb % nxcd, kk = vb / nxcd;
  for (int r = 0;; ++r) {
    int L = (r * nxcd + x) * per + kk;
    if (L >= ntiles) { if ((r * nxcd) * per >= ntiles) break; else continue; }
    int band = L / (4 * Ntiles);
    int rem = L - band * 4 * Ntiles;
    int bm = Mtiles - band * 4; if (bm > 4) bm = 4;
    int nt = rem / bm, mi = rem - nt * bm;
    int mt = band * 4 + mi;
    const bf16_t* Ap = A;
    if (a_mode == 1) Ap = A + (nt >> 1) * 128;
    gemm_tile<EPI>(p, ea, Ap, lda, Bt, K, mt * 256, nt * 128, smem);
  }
}

__device__ __forceinline__ int mchunk_tok(int dir, int j, int r) {
  if (dir == 0) return j * 64 + r;
  int c = (j < 4) ? (3 - j) : (135 - j);
  return c * 64 + 63 - r;
}

__device__ __forceinline__ void m1_phase(const Params& p, char* smem) {
  const int tid = otid(), lane = tid & 63, w = tid >> 6, fr = lane & 15, fq = lane >> 4;
  for (int row = obid() * 8 + w; row < NTOK; row += gridDim.x * 8) {
    const bf16_t* pr = p.ACT() + (size_t)row * PW;
    float sq = 0, skv = 0;
#pragma unroll
    for (int i = 0; i < 6; ++i) { float v = bf2f(pr[i * 64 + lane]); sq += v * v; }
#pragma unroll
    for (int i = 0; i < 4; ++i) { float v = bf2f(pr[384 + i * 64 + lane]); skv += v * v; }
    sq = wave_sum(sq); skv = wave_sum(skv);
    if (lane == 0) {
      p.RS()[(size_t)row * 2] = rsqrtf(sq * (1.0f / 384.0f) + 1e-6f);
      p.RS()[(size_t)row * 2 + 1] = rsqrtf(skv * (1.0f / 256.0f) + 1e-6f);
    }
    if (lane < 32) p.KR()[(size_t)row * 32 + lane] = pr[640 + lane];
  }
  bf16_t* Kt = (bf16_t*)smem;
  bf16_t* Vt = Kt + 128 * 72;
  float* wv = (float*)(Vt + 128 * 72);
  for (int it = obid(); it < NCHAIN * NCHUNK; it += gridDim.x) {
    int ci = it / NCHUNK, j = it - ci * NCHUNK;
    int dir = ci & 1, h = (ci >> 1) & 3, b = ci >> 3;
    int rowbase = b * TPB;
    if (w == 0) {
      int row = rowbase + mchunk_tok(dir, j, lane);
      float gi = p.G()[(size_t)row * 16 + (2 * dir) * 4 + h] + p.mlstm_gate_b[(2 * dir) * 4 + h];
      float gf = p.G()[(size_t)row * 16 + (2 * dir + 1) * 4 + h] + p.mlstm_gate_b[(2 * dir + 1) * 4 + h];
      float bsum = logsigmoidf_(gf);
#pragma unroll
      for (int o = 1; o < 64; o <<= 1) { float t = __shfl_up(bsum, o); if (lane >= o) bsum += t; }
      float be = __shfl(bsum, 63);
      float gg = be - bsum + gi;
      float ml = wave_max(gg);
      wv[lane] = __expf(gg - ml);
      if (lane == 0) { p.mloc()[it] = ml; p.bend()[it] = be; }
    }
    __syncthreads();
#pragma unroll
    for (int i = 0; i < 2; ++i) {
      int idx = tid + i * NTHR;
      int r = idx & 63, fc = (idx >> 6) * 8;
      int row = rowbase + mchunk_tok(dir, j, r);
      const bf16_t* src = p.ACT() + (size_t)row * PW;
      uint4 kv = *(const uint4*)(src + 1184 + h * 128 + fc);
      uint4 vv = *(const uint4*)(src + 1696 + h * 128 + fc);
      float wr = wv[r];
      const bf16_t* ke = (const bf16_t*)&kv; const bf16_t* ve = (const bf16_t*)&vv;
#pragma unroll
      for (int e = 0; e < 8; ++e) {
        Kt[(fc + e) * 72 + r] = ke[e];
        Vt[(fc + e) * 72 + r] = f2bf(bf2f(ve[e]) * wr);
      }
    }
    __syncthreads();
    f32x4 acc[8];
#pragma unroll
    for (int ni = 0; ni < 8; ++ni) acc[ni] = (f32x4){0.f, 0.f, 0.f, 0.f};
#pragma unroll
    for (int ks = 0; ks < 2; ++ks) {
      bf16x8 a = *(const bf16x8*)(Vt + (w * 16 + fr) * 72 + ks * 32 + fq * 8);
#pragma unroll
      for (int ni = 0; ni < 8; ++ni) {
        bf16x8 bb = *(const bf16x8*)(Kt + (ni * 16 + fr) * 72 + ks * 32 + fq * 8);
        acc[ni] = MFMA16(a, bb, acc[ni]);
      }
    }
    bf16_t* dC = p.R() + (size_t)it * 16384;
#pragma unroll
    for (int ni = 0; ni < 8; ++ni)
#pragma unroll
      for (int jj = 0; jj < 4; ++jj) dC[(w * 16 + fq * 4 + jj) * 128 + ni * 16 + fr] = f2bf(acc[ni][jj]);
    if (tid < 128) {
      float s = 0;
#pragma unroll 8
      for (int r = 0; r < 64; ++r) s += wv[r] * bf2f(Kt[tid * 72 + r]);
      p.dn()[(size_t)it * 128 + tid] = s;
    }
    __syncthreads();
  }
}

__device__ __forceinline__ void m2_phase(const Params& p) {
  const int tid = otid();
  for (int it = obid(); it < NCHAIN * 16; it += gridDim.x) {
    int ci = it >> 4, sl = it & 15;
    float C0 = 0, C1 = 0, m = 0, nn = 0;
    const bool don = (sl == 0 && tid < 128);
    uint32_t* base = (uint32_t*)(p.R() + (size_t)ci * NCHUNK * 16384 + sl * 1024) + tid;
    constexpr int GRP = 33;
#pragma unroll 1
    for (int j0 = 0; j0 < NCHUNK; j0 += GRP) {
      uint32_t d[GRP]; float ml[GRP], be[GRP], dnv[GRP];
#pragma unroll
      for (int q = 0; q < GRP; ++q) {
        int sidx = ci * NCHUNK + j0 + q;
        d[q] = base[(size_t)(j0 + q) * 8192];
        ml[q] = p.mloc()[sidx]; be[q] = p.bend()[sidx];
        dnv[q] = don ? p.dn()[(size_t)sidx * 128 + tid] : 0.0f;
      }
#pragma unroll
      for (int q = 0; q < GRP; ++q) {
        int sidx = ci * NCHUNK + j0 + q;
        base[(size_t)(j0 + q) * 8192] = pack2(C0, C1);
        if (don) p.nst()[(size_t)sidx * 128 + tid] = nn;
        if (sl == 0 && tid == 0) p.mst()[sidx] = m;
        float mn = fmaxf(be[q] + m, ml[q]);
        float a = __expf(be[q] + m - mn), bb = __expf(ml[q] - mn);
        C0 = a * C0 + bb * lo2f(d[q]);
        C1 = a * C1 + bb * hi2f(d[q]);
        nn = a * nn + bb * dnv[q];
        m = mn;
      }
    }
  }
}

__device__ __forceinline__ void m3_phase(const Params& p, char* smem) {
  const int tid = otid(), lane = tid & 63, w = tid >> 6, fr = lane & 15, fq = lane >> 4;
  bf16_t* Qs = (bf16_t*)smem;
  bf16_t* Ks = Qs + 64 * 136;
  bf16_t* Vt = Ks + 64 * 136;
  bf16_t* Cs = Vt + 128 * 72;
  bf16_t* Sw = Cs + 128 * 136;
  float* hs = (float*)(Sw + 64 * 72);
  float* cs = hs + 64 * 132;
  float* rt = cs + 64;
  float* wint = rt + 64;
  float* emt = wint + 64;
  float* qn = emt + 64;
  float* denp = qn + 64;
  float* ns = denp + 128;
  bf16_t* MIX = p.H();
  for (int it = obid(); it < 8 * NCHUNK; it += gridDim.x) {
    int bh = it / NCHUNK, c = it - bh * NCHUNK;
    int b = bh >> 2, h = bh & 3;
    int rowbase = b * TPB;
    for (int dir = 0; dir < 2; ++dir) {
      int ci = (b * 4 + h) * 2 + dir;
      int j = (dir == 0) ? c : ((c < 4) ? (3 - c) : (135 - c));
      int sidx = ci * NCHUNK + j;
      if (w == 0) {
        int row = rowbase + mchunk_tok(dir, j, lane);
        float gi = p.G()[(size_t)row * 16 + (2 * dir) * 4 + h] + p.mlstm_gate_b[(2 * dir) * 4 + h];
        float gf = p.G()[(size_t)row * 16 + (2 * dir + 1) * 4 + h] + p.mlstm_gate_b[(2 * dir + 1) * 4 + h];
        float bsum = logsigmoidf_(gf);
#pragma unroll
        for (int o = 1; o < 64; o <<= 1) { float t = __shfl_up(bsum, o); if (lane >= o) bsum += t; }
        float cv = gi - bsum;
        float pm = cv;
#pragma unroll
        for (int o = 1; o < 64; o <<= 1) { float t = __shfl_up(pm, o); if (lane >= o) pm = fmaxf(pm, t); }
        float mprev = p.mst()[sidx];
        float mt = fmaxf(bsum + mprev, bsum + pm);
        cs[lane] = cv;
        rt[lane] = bsum - mt;
        wint[lane] = __expf(bsum + mprev - mt);
        emt[lane] = __expf(-mt);
      }
      if (tid < 128) ns[tid] = p.nst()[(size_t)sidx * 128 + tid];
#pragma unroll
      for (int i = 0; i < 2; ++i) {
        int idx = tid + i * NTHR;
        int r = idx & 63, fc = (idx >> 6) * 8;
        int row = rowbase + mchunk_tok(dir, j, r);
        const bf16_t* src = p.ACT() + (size_t)row * PW;
        uint4 qv = *(const uint4*)(src + 672 + h * 128 + fc);
        uint4 kv = *(const uint4*)(src + 1184 + h * 128 + fc);
        uint4 vv = *(const uint4*)(src + 1696 + h * 128 + fc);
        *(uint4*)(Qs + r * 136 + fc) = qv;
        *(uint4*)(Ks + r * 136 + fc) = kv;
        const bf16_t* ve = (const bf16_t*)&vv;
#pragma unroll
        for (int e = 0; e < 8; ++e) Vt[(fc + e) * 72 + r] = ve[e];
      }
      {
        const bf16_t* cst = p.R() + (size_t)sidx * 16384;
#pragma unroll
        for (int i = 0; i < 4; ++i) {
          int idx = tid + i * NTHR;
          int v = idx >> 4, kc = (idx & 15) * 8;
          *(uint4*)(Cs + v * 136 + kc) = *(const uint4*)(cst + v * 128 + kc);
        }
      }
      __syncthreads();
      {
        const int mi = w & 3, nb2 = (w >> 2) * 2;
        f32x4 s2[2] = {(f32x4){0.f, 0.f, 0.f, 0.f}, (f32x4){0.f, 0.f, 0.f, 0.f}};
#pragma unroll
        for (int ks = 0; ks < 4; ++ks) {
          bf16x8 a = *(const bf16x8*)(Qs + (mi * 16 + fr) * 136 + ks * 32 + fq * 8);
#pragma unroll
          for (int q = 0; q < 2; ++q) {
            bf16x8 bb = *(const bf16x8*)(Ks + ((nb2 + q) * 16 + fr) * 136 + ks * 32 + fq * 8);
            s2[q] = MFMA16(a, bb, s2[q]);
          }
        }
        float rsum[4] = {0, 0, 0, 0};
#pragma unroll
        for (int q = 0; q < 2; ++q) {
          int s = (nb2 + q) * 16 + fr;
          float csv = cs[s];
#pragma unroll
          for (int jj = 0; jj < 4; ++jj) {
            int t = mi * 16 + fq * 4 + jj;
            float wgt = (s <= t) ? __expf(rt[t] + csv) : 0.0f;
            bf16_t hb = f2bf(s2[q][jj] * wgt);
            Sw[t * 72 + s] = hb;
            rsum[jj] += bf2f(hb);
          }
        }
#pragma unroll
        for (int jj = 0; jj < 4; ++jj) {
          float v = rsum[jj];
          v += __shfl_xor(v, 1); v += __shfl_xor(v, 2); v += __shfl_xor(v, 4); v += __shfl_xor(v, 8);
          if (fr == 0) denp[(w >> 2) * 64 + mi * 16 + fq * 4 + jj] = v;
        }
        {
          int t = tid >> 3, k0 = (tid & 7) * 16;
          float s = 0;
#pragma unroll
          for (int k = 0; k < 16; ++k) s += bf2f(Qs[t * 136 + k0 + k]) * ns[k0 + k];
          s += __shfl_xor(s, 1); s += __shfl_xor(s, 2); s += __shfl_xor(s, 4);
          if ((tid & 7) == 0) qn[t] = s;
        }
      }
      __syncthreads();
      {
        const int mi = w & 3, nh = w >> 2;
        f32x4 a1[4], a2[4];
#pragma unroll
        for (int q = 0; q < 4; ++q) { a1[q] = (f32x4){0.f, 0.f, 0.f, 0.f}; a2[q] = (f32x4){0.f, 0.f, 0.f, 0.f}; }
#pragma unroll
        for (int ks = 0; ks < 2; ++ks) {
          bf16x8 a = *(const bf16x8*)(Sw + (mi * 16 + fr) * 72 + ks * 32 + fq * 8);
#pragma unroll
          for (int q = 0; q < 4; ++q) {
            bf16x8 bb = *(const bf16x8*)(Vt + ((nh * 4 + q) * 16 + fr) * 72 + ks * 32 + fq * 8);
            a1[q] = MFMA16(a, bb, a1[q]);
          }
        }
#pragma unroll
        for (int ks = 0; ks < 4; ++ks) {
          bf16x8 a = *(const bf16x8*)(Qs + (mi * 16 + fr) * 136 + ks * 32 + fq * 8);
#pragma unroll
          for (int q = 0; q < 4; ++q) {
            bf16x8 bb = *(const bf16x8*)(Cs + ((nh * 4 + q) * 16 + fr) * 136 + ks * 32 + fq * 8);
            a2[q] = MFMA16(a, bb, a2[q]);
          }
        }
#pragma unroll
        for (int jj = 0; jj < 4; ++jj) {
          int t = mi * 16 + fq * 4 + jj;
          float wi = wint[t];
          float den = denp[t] + denp[64 + t] + wi * qn[t];
          float inv = 1.0f / fmaxf(fabsf(den), emt[t]);
          int tl = (dir == 0) ? t : (63 - t);
#pragma unroll
          for (int q = 0; q < 4; ++q) {
            int v = (nh * 4 + q) * 16 + fr;
            float hv = (a1[q][jj] + wi * a2[q][jj]) * inv;
            if (dir == 0) hs[tl * 132 + v] = hv; else hs[tl * 132 + v] += hv;
          }
        }
      }
      __syncthreads();
    }
    for (int q = 0; q < 8; ++q) {
      int tl = w * 8 + q;
      float v0 = hs[tl * 132 + lane], v1 = hs[tl * 132 + 64 + lane];
      float ss = wave_sum(v0 * v0 + v1 * v1);
      float rstd = rsqrtf(ss * (1.0f / 128.0f) + 1e-6f);
      int row = rowbase + c * 64 + tl;
      const bf16_t* po = p.ACT() + (size_t)row * PW + 2208 + h * 128;
      float o0 = bf2f(po[lane]), o1 = bf2f(po[64 + lane]);
      float y0 = v0 * rstd * p.mlstm_out_g[h * 128 + lane] * sigmoidf_(o0);
      float y1 = v1 * rstd * p.mlstm_out_g[h * 128 + 64 + lane] * sigmoidf_(o1);
      MIX[(size_t)row * D + 512 + h * 128 + lane] = f2bf(y0);
      MIX[(size_t)row * D + 512 + h * 128 + 64 + lane] = f2bf(y1);
    }
    __syncthreads();
  }
}

__device__ __forceinline__ void norm_rope_32(float* x, const float* g, bool latent, int t, const float2* tab) {
  float ss = 0;
#pragma unroll
  for (int i = 0; i < 32; ++i) ss += x[i] * x[i];
  float rstd = rsqrtf(ss * (1.0f / 32.0f) + 1e-6f);
#pragma unroll
  for (int i = 0; i < 32; ++i) x[i] = x[i] * rstd * g[i];
  if (latent) {
#pragma unroll
    for (int a = 0; a < 2; ++a) {
      const int pos = (a == 0 ? (t >> 6) : (t & 63));
#pragma unroll
      for (int i = 0; i < 8; ++i) {
        float2 cs = tab[pos * 8 + i];
        float x1 = x[a * 16 + i], x2 = x[a * 16 + 8 + i];
        x[a * 16 + i] = x1 * cs.x - x2 * cs.y;
        x[a * 16 + 8 + i] = x2 * cs.x + x1 * cs.y;
      }
    }
  }
}

__device__ __forceinline__ void load32(const bf16_t* src, float* x) {
  const uint4* s4 = (const uint4*)src;
#pragma unroll
  for (int i = 0; i < 4; ++i) {
    uint4 v = s4[i];
    x[i * 8 + 0] = lo2f(v.x); x[i * 8 + 1] = hi2f(v.x); x[i * 8 + 2] = lo2f(v.y); x[i * 8 + 3] = hi2f(v.y);
    x[i * 8 + 4] = lo2f(v.z); x[i * 8 + 5] = hi2f(v.z); x[i * 8 + 6] = lo2f(v.w); x[i * 8 + 7] = hi2f(v.w);
  }
}
__device__ __forceinline__ void post_phase(const Params& p) {
  const bf16_t* QRAW = p.R();
  const bf16_t* KVRAW = p.R() + (size_t)NTOK * 768;
  bf16_t* Qo = p.ACT();
  bf16_t* Ko = p.ACT() + (size_t)16 * TPB * 96;
  const float qscale = 0.10206207261596577f * 1.4426950408889634f;
  const int tid = otid();
  for (int gi = obid() * NTHR + tid; gi < 4 * NTOK * 8; gi += gridDim.x * NTHR) {
    const int part = gi / (NTOK * 8);
    const int idx = gi - part * (NTOK * 8);
    int row = idx >> 3, h = idx & 7;
    int b = row >= TPB ? 1 : 0, u = row - b * TPB;
    bool latent = u >= CTX; int t = u - CTX;
    size_t obase = ((size_t)(b * 8 + h) * TPB + u) * 96;
    float knorm2 = 0.f;
    if (part < 2) {
      const bf16_t* src = part == 0 ? QRAW + (size_t)row * 768 + h * 96 : KVRAW + (size_t)row * 1024 + h * 128;
      const float* gn = part == 0 ? p.mla_q_g : p.mla_k_g;
      float x[64]; float ss = 0;
      load32(src, x); load32(src + 32, x + 32);
#pragma unroll
      for (int i = 0; i < 64; ++i) ss += x[i] * x[i];
      float rstd = rsqrtf(ss * (1.0f / 64.0f) + 1e-6f) * (part == 0 ? qscale : 1.0f);
      uint4* dst = (uint4*)((part == 0 ? Qo : Ko) + obase);
#pragma unroll
      for (int i = 0; i < 8; ++i) {
        float y[8];
#pragma unroll
        for (int e = 0; e < 8; ++e) { y[e] = x[i * 8 + e] * rstd * gn[i * 8 + e]; knorm2 += y[e] * y[e]; }
        uint4 o;
        o.x = pack2(y[0], y[1]); o.y = pack2(y[2], y[3]); o.z = pack2(y[4], y[5]); o.w = pack2(y[6], y[7]);
        dst[i] = o;
      }
    } else {
      const bf16_t* src = part == 2 ? QRAW + (size_t)row * 768 + h * 96 + 64 : p.KR() + (size_t)row * 32;
      float x[32];
      load32(src, x);
      norm_rope_32(x, (part == 2 ? p.mla_q_g : p.mla_k_g) + 64, latent, t, p.ropetab());
      const float sc = part == 2 ? qscale : 1.0f;
      uint4* dst = (uint4*)((part == 2 ? Qo : Ko) + obase + 64);
#pragma unroll
      for (int i = 0; i < 4; ++i) {
        float y[8];
#pragma unroll
        for (int e = 0; e < 8; ++e) { y[e] = x[i * 8 + e] * sc; knorm2 += y[e] * y[e]; }
        uint4 o;
        o.x = pack2(y[0], y[1]); o.y = pack2(y[2], y[3]); o.z = pack2(y[4], y[5]); o.w = pack2(y[6], y[7]);
        dst[i] = o;
      }
    }
    if (part == 1 || part == 3) {
      knorm2 = fmaxf(knorm2, __shfl_xor(knorm2, 8));
      knorm2 = fmaxf(knorm2, __shfl_xor(knorm2, 16));
      knorm2 = fmaxf(knorm2, __shfl_xor(knorm2, 32));
      if ((tid & 63) < 8) atomicMax(p.kmax2() + (part == 1 ? 0 : 16) + (b * 8 + h), __float_as_uint(knorm2));
    }
  }
}

__device__ __forceinline__ void vt_scatter(bf16_t* dst, int stride, uint4 v) {
  dst[0 * stride] = (bf16_t)(v.x & 0xFFFF); dst[1 * stride] = (bf16_t)(v.x >> 16);
  dst[2 * stride] = (bf16_t)(v.y & 0xFFFF); dst[3 * stride] = (bf16_t)(v.y >> 16);
  dst[4 * stride] = (bf16_t)(v.z & 0xFFFF); dst[5 * stride] = (bf16_t)(v.z >> 16);
  dst[6 * stride] = (bf16_t)(v.w & 0xFFFF); dst[7 * stride] = (bf16_t)(v.w >> 16);
}
constexpr int KLD = 104, VLD = 136, KT = 128;
__device__ __forceinline__ void attn_phase(const Params& p, char* smem) {
  const int tid = otid(), lane = tid & 63, w = tid >> 6, fr = lane & 15, fq = lane >> 4;
  bf16_t* Ks = (bf16_t*)smem;
  bf16_t* Vt = Ks + 2 * KT * KLD;
  const bf16_t* Qg = p.ACT();
  const bf16_t* Kg = p.ACT() + (size_t)16 * TPB * 96;
  const bf16_t* KVRAW = p.R() + (size_t)NTOK * 768;
  bf16_t* MIX = p.H();
  for (int it = obid(); it < 272; it += gridDim.x) {
    int bh, qu0, nq, nkeys;
    if (it < 256) { int xx = it & 7, k = it >> 3; bh = 2 * xx + (k >> 4); qu0 = CTX + (k & 15) * 512; nq = 512; nkeys = TPB; }
    else { bh = it - 256; qu0 = 0; nq = 256; nkeys = CTX; }
    const int b = bh >> 3, h = bh & 7;
    const bool active = (w * 64) < nq;
    bf16x8 qf[4][3];
    if (active) {
#pragma unroll
      for (int g = 0; g < 4; ++g) {
        const bf16_t* qp = Qg + ((size_t)bh * TPB + qu0 + w * 64 + g * 16 + fr) * 96 + fq * 8;
#pragma unroll
        for (int ds = 0; ds < 3; ++ds) qf[g][ds] = *(const bf16x8*)(qp + ds * 32);
      }
    }
    f32x4 oT[4][4];
    float mneg[4], lrun[4];
    float bmax = 0.f;
    {
      const float kmx = sqrtf(__uint_as_float(p.kmax2()[bh]) + __uint_as_float(p.kmax2()[16 + bh])) * 1.01f;
#pragma unroll
      for (int g = 0; g < 4; ++g) {
        float qs = 0.f;
        if (active) {
#pragma unroll
          for (int ds = 0; ds < 3; ++ds)
#pragma unroll
            for (int e = 0; e < 8; ++e) { float qv = bf2f((bf16_t)qf[g][ds][e]); qs += qv * qv; }
        }
        qs += __shfl_xor(qs, 16); qs += __shfl_xor(qs, 32);
        mneg[g] = -sqrtf(qs) * kmx;
        bmax = fmaxf(bmax, -mneg[g]);
        lrun[g] = 0.f;
#pragma unroll
        for (int q = 0; q < 4; ++q) oT[g][q] = (f32x4){0.f, 0.f, 0.f, 0.f};
      }
    }
    const bool stab = __any(bmax > 60.0f) != 0;
    const bf16_t* kbase = Kg + (size_t)bh * TPB * 96;
    const bf16_t* vbase = KVRAW + (size_t)b * TPB * 1024 + h * 128 + 64;
#define kgo ((tid >> 2) * 96 + (tid & 3) * 24)
#define klo ((tid >> 2) * KLD + (tid & 3) * 24)
#define vkey0 (tid >> 3)
#define vch (tid & 7)
    uint4 rk0, rk1, rk2, rv0, rv1;
    const int nkt = nkeys / KT;
    rk0 = *(const uint4*)(kbase + kgo); rk1 = *(const uint4*)(kbase + kgo + 8); rk2 = *(const uint4*)(kbase + kgo + 16);
    rv0 = *(const uint4*)(vbase + (size_t)vkey0 * 1024 + vch * 8); rv1 = *(const uint4*)(vbase + (size_t)(vkey0 + 64) * 1024 + vch * 8);
    {
      *(uint4*)(Ks + klo) = rk0; *(uint4*)(Ks + klo + 8) = rk1; *(uint4*)(Ks + klo + 16) = rk2;
      vt_scatter(Vt + (vch * 8) * VLD + vkey0, VLD, rv0); vt_scatter(Vt + (vch * 8) * VLD + vkey0 + 64, VLD, rv1);
    }
    __syncthreads();
    for (int kt = 0; kt < nkt; ++kt) {
      const int buf = kt & 1;
      if (kt + 1 < nkt) {
        size_t ko = (size_t)(kt + 1) * KT;
        rk0 = *(const uint4*)(kbase + ko * 96 + kgo); rk1 = *(const uint4*)(kbase + ko * 96 + kgo + 8); rk2 = *(const uint4*)(kbase + ko * 96 + kgo + 16);
        rv0 = *(const uint4*)(vbase + (ko + vkey0) * 1024 + vch * 8); rv1 = *(const uint4*)(vbase + (ko + vkey0 + 64) * 1024 + vch * 8);
      }
      if (active) {
        const bf16_t* cK = Ks + buf * KT * KLD;
        const bf16_t* cV = Vt + buf * 64 * VLD;
#pragma unroll 1
        for (int ks = 0; ks < 4; ++ks) {
          uint32_t pfu[4][4];
#pragma unroll
          for (int kf = 0; kf < 2; ++kf) {
            f32x4 sT[4];
#pragma unroll
            for (int g = 0; g < 4; ++g) sT[g] = (f32x4){0.f, 0.f, 0.f, 0.f};
#pragma unroll
            for (int ds = 0; ds < 3; ++ds) {
              bf16x8 ka = *(const bf16x8*)(cK + (ks * 32 + kf * 16 + fr) * KLD + ds * 32 + fq * 8);
#pragma unroll
              for (int g = 0; g < 4; ++g) sT[g] = MFMA16(ka, qf[g][ds], sT[g]);
            }
            if (stab) {
#pragma unroll
              for (int g = 0; g < 4; ++g) { sT[g][0] += mneg[g]; sT[g][1] += mneg[g]; sT[g][2] += mneg[g]; sT[g][3] += mneg[g]; }
            }
#pragma unroll
            for (int g = 0; g < 4; ++g) {
              float p0 = __builtin_amdgcn_exp2f(sT[g][0]), p1 = __builtin_amdgcn_exp2f(sT[g][1]);
              float p2 = __builtin_amdgcn_exp2f(sT[g][2]), p3 = __builtin_amdgcn_exp2f(sT[g][3]);
              { float l_ = lrun[g]; l_ += p0; l_ += p1; l_ += p2; l_ += p3; lrun[g] = l_; }
              pfu[g][kf * 2] = pack2(p0, p1); pfu[g][kf * 2 + 1] = pack2(p2, p3);
            }
          }
          bf16x8 pf[4];
#pragma unroll
          for (int g = 0; g < 4; ++g) {
            union { uint32_t u[4]; bf16x8 v; } cvt;
            cvt.u[0] = pfu[g][0]; cvt.u[1] = pfu[g][1]; cvt.u[2] = pfu[g][2]; cvt.u[3] = pfu[g][3];
            pf[g] = cvt.v;
          }
#pragma unroll
          for (int dvf = 0; dvf < 4; ++dvf) {
            const bf16_t* vp = cV + (dvf * 16 + fr) * VLD + ks * 32 + fq * 4;
            union { uint2 u[2]; bf16x8 v; } va;
            va.u[0] = *(const uint2*)(vp);
            va.u[1] = *(const uint2*)(vp + 16);
#pragma unroll
            for (int g = 0; g < 4; ++g) oT[g][dvf] = MFMA16(va.v, pf[g], oT[g][dvf]);
          }
        }
      }
      if (kt + 1 < nkt) {
        bf16_t* dK = Ks + (buf ^ 1) * KT * KLD;
        bf16_t* dV = Vt + (buf ^ 1) * 64 * VLD;
        *(uint4*)(dK + klo) = rk0; *(uint4*)(dK + klo + 8) = rk1; *(uint4*)(dK + klo + 16) = rk2;
        vt_scatter(dV + (vch * 8) * VLD + vkey0, VLD, rv0); vt_scatter(dV + (vch * 8) * VLD + vkey0 + 64, VLD, rv1);
      }
      __syncthreads();
    }
    if (active) {
#pragma unroll
      for (int g = 0; g < 4; ++g) {
        float l = lrun[g];
        l += __shfl_xor(l, 16); l += __shfl_xor(l, 32);
        float inv = 1.0f / l;
        int row = b * TPB + qu0 + w * 64 + g * 16 + fr;
#pragma unroll
        for (int dvf = 0; dvf < 4; ++dvf) {
          uint2 o;
          o.x = pack2(oT[g][dvf][0] * inv, oT[g][dvf][1] * inv);
          o.y = pack2(oT[g][dvf][2] * inv, oT[g][dvf][3] * inv);
          *(uint2*)(MIX + (size_t)row * D + h * 64 + dvf * 16 + fq * 4) = o;
        }
      }
    }
  }
}

#undef kgo
#undef klo
#undef vkey0
#undef vch
__device__ __forceinline__ void conv_phase(const Params& p) {
  const bf16_t* O1 = p.ACT();
  for (int idx = obid() * NTHR + otid(); idx < NTOK * 128; idx += gridDim.x * NTHR) {
    int row = idx >> 7, cc = (idx & 127) * 8;
    int b = row >= TPB ? 1 : 0, u = row - b * TPB;
    int lo = (u < CTX) ? 0 : CTX, hi = (u < CTX) ? CTX : TPB;
    float acc[8];
#pragma unroll
    for (int e = 0; e < 8; ++e) acc[e] = p.odd_conv_b[cc + e];
#pragma unroll
    for (int k = 0; k < 4; ++k) {
      int uu = u + k - 2;
      if (uu >= lo && uu < hi) {
        uint4 v = *(const uint4*)(O1 + (size_t)(row + k - 2) * 2048 + 1024 + cc);
        const float* wk = p.odd_conv_w + k * 1024 + cc;
        acc[0] += wk[0] * lo2f(v.x); acc[1] += wk[1] * hi2f(v.x);
        acc[2] += wk[2] * lo2f(v.y); acc[3] += wk[3] * hi2f(v.y);
        acc[4] += wk[4] * lo2f(v.z); acc[5] += wk[5] * hi2f(v.z);
        acc[6] += wk[6] * lo2f(v.w); acc[7] += wk[7] * hi2f(v.w);
      }
    }
    uint4 o;
    o.x = pack2(acc[0], acc[1]); o.y = pack2(acc[2], acc[3]); o.z = pack2(acc[4], acc[5]); o.w = pack2(acc[6], acc[7]);
    *(uint4*)(p.XC() + (size_t)row * D + cc) = o;
  }
}

__device__ __forceinline__ int scan_tok(int dir, int pi) {
  if (dir == 0) return pi;
  return (pi < CTX) ? (CTX - 1 - pi) : (TPB + CTX - 1 - pi);
}

__device__ __forceinline__ void scan_step4(uint4 v, float (&h)[4]) {
  h[0] = __expf(lo2f(v.x)) * h[0] + hi2f(v.x);
  h[1] = __expf(lo2f(v.y)) * h[1] + hi2f(v.y);
  h[2] = __expf(lo2f(v.z)) * h[2] + hi2f(v.z);
  h[3] = __expf(lo2f(v.w)) * h[3] + hi2f(v.w);
}
__device__ __forceinline__ void scan1_phase(const Params& p, int dir) {
  const int tid = otid(), lane = tid & 63, w = tid >> 6;
  const uint32_t* RG = (const uint32_t*)p.R();
  float* const suma = p.SUMA(); float* const sumh = p.SUMH();
  for (int it = obid(); it < 256; it += gridDim.x) {
    const int b = it >> 7, cgp = (it >> 5) & 3, seg = it & 31;
    const int ch0 = cgp * 256 + lane * 4;
    const size_t rb = (size_t)b * TPB;
    const int pos0 = seg * 264 + w * 33;
    float h[4] = {0.f, 0.f, 0.f, 0.f}, as[4] = {0.f, 0.f, 0.f, 0.f};
    {
      uint4 v[33];
#pragma unroll
      for (int i = 0; i < 33; ++i) v[i] = *(const uint4*)(RG + (rb + scan_tok(dir, pos0 + i)) * D + ch0);
#pragma unroll
      for (int i = 0; i < 33; ++i) {
        scan_step4(v[i], h);
        as[0] += lo2f(v[i].x); as[1] += lo2f(v[i].y); as[2] += lo2f(v[i].z); as[3] += lo2f(v[i].w);
      }
    }
    const size_t e = ((size_t)(b * 4 + cgp) * 264 + seg * 8 + w) * 256 + lane * 4;
    *(float4*)(suma + e) = make_float4(as[0], as[1], as[2], as[3]);
    *(float4*)(sumh + e) = make_float4(h[0], h[1], h[2], h[3]);
  }
}
__device__ __forceinline__ void scan2_phase(const Params& p, int dir, char* smem) {
  const int tid = otid(), lane = tid & 63, w = tid >> 6;
  const uint32_t* RG = (const uint32_t*)p.R();
  float* const suma = p.SUMA(); float* const sumh = p.SUMH();
  const bf16_t* O1 = p.ACT();
  bf16_t* Y = p.H();
  float4* pA = (float4*)smem;
  float4* pH = pA + 512;
  for (int it = obid(); it < 256; it += gridDim.x) {
    const int b = it >> 7, cgp = (it >> 5) & 3, seg = it & 31;
    const int ch0 = cgp * 256 + lane * 4;
    const size_t rb = (size_t)b * TPB;
    const int pos0 = seg * 264 + w * 33;
    const size_t sb = ((size_t)(b * 4 + cgp) * 264) * 256 + lane * 4;
    {
      float a4[4] = {0.f, 0.f, 0.f, 0.f}, h4[4] = {0.f, 0.f, 0.f, 0.f};
#pragma unroll 1
      for (int q0 = 0; q0 < seg; q0 += 16) {
        float4 A[16], Hh[16];
#pragma unroll
        for (int i = 0; i < 16; ++i) {
          A[i] = make_float4(0.f, 0.f, 0.f, 0.f); Hh[i] = A[i];
          if (q0 + i < seg) { size_t e = sb + (size_t)(w * seg + q0 + i) * 256; A[i] = *(const float4*)(suma + e); Hh[i] = *(const float4*)(sumh + e); }
        }
#pragma unroll
        for (int i = 0; i < 16; ++i) {
          h4[0] = __expf(A[i].x) * h4[0] + Hh[i].x; h4[1] = __expf(A[i].y) * h4[1] + Hh[i].y; h4[2] = __expf(A[i].z) * h4[2] + Hh[i].z; h4[3] = __expf(A[i].w) * h4[3] + Hh[i].w;
          a4[0] += A[i].x; a4[1] += A[i].y; a4[2] += A[i].z; a4[3] += A[i].w;
        }
      }
      pA[w * 64 + lane] = make_float4(a4[0], a4[1], a4[2], a4[3]);
      pH[w * 64 + lane] = make_float4(h4[0], h4[1], h4[2], h4[3]);
    }
    __syncthreads();
    float h[4] = {0.f, 0.f, 0.f, 0.f};
#pragma unroll
    for (int q = 0; q < 8; ++q) {
      float4 A = pA[q * 64 + lane], Hh = pH[q * 64 + lane];
      h[0] = __expf(A.x) * h[0] + Hh.x; h[1] = __expf(A.y) * h[1] + Hh.y; h[2] = __expf(A.z) * h[2] + Hh.z; h[3] = __expf(A.w) * h[3] + Hh.w;
    }
    {
      float4 A[7], Hh[7];
#pragma unroll
      for (int q = 0; q < 7; ++q) {
        A[q] = make_float4(0.f, 0.f, 0.f, 0.f); Hh[q] = A[q];
        if (q < w) { size_t e = sb + (size_t)(seg * 8 + q) * 256; A[q] = *(const float4*)(suma + e); Hh[q] = *(const float4*)(sumh + e); }
      }
#pragma unroll
      for (int q = 0; q < 7; ++q) {
        h[0] = __expf(A[q].x) * h[0] + Hh[q].x; h[1] = __expf(A[q].y) * h[1] + Hh[q].y; h[2] = __expf(A[q].z) * h[2] + Hh[q].z; h[3] = __expf(A[q].w) * h[3] + Hh[q].w;
      }
    }
#pragma unroll 1
    for (int bt = 0; bt < 3; ++bt) {
      uint4 v[11]; uint2 hf[11], gt[11];
#pragma unroll
      for (int i = 0; i < 11; ++i) {
        size_t row = rb + scan_tok(dir, pos0 + bt * 11 + i);
        v[i] = *(const uint4*)(RG + row * D + ch0);
        if (dir == 1) { hf[i] = *(const uint2*)(Y + row * D + ch0); gt[i] = *(const uint2*)(O1 + row * 2048 + ch0); }
      }
#pragma unroll
      for (int i = 0; i < 11; ++i) {
        size_t row = rb + scan_tok(dir, pos0 + bt * 11 + i);
        scan_step4(v[i], h);
        uint2 o;
        if (dir == 0) { o.x = pack2(h[0], h[1]); o.y = pack2(h[2], h[3]); }
        else {
          float y0 = (lo2f(hf[i].x) + h[0]) * gelu_tanh(lo2f(gt[i].x));
          float y1 = (hi2f(hf[i].x) + h[1]) * gelu_tanh(hi2f(gt[i].x));
          float y2 = (lo2f(hf[i].y) + h[2]) * gelu_tanh(lo2f(gt[i].y));
          float y3 = (hi2f(hf[i].y) + h[3]) * gelu_tanh(hi2f(gt[i].y));
          o.x = pack2(y0, y1); o.y = pack2(y2, y3);
        }
        *(uint2*)(Y + row * D + ch0) = o;
      }
    }
    __syncthreads();
  }
}

#define XB_TMO      128
#define XB_XCNT(j)  (256  + 64 * (j))
#define XB_XSUB(j)  (1280 + 64 * (j))
#define XB_XGEN(j)  (2304 + 64 * (j))
#define XB_TOP      3328
#define XB_TOPGEN   3392
#define XCD_BAR_WORDS 3456
#define XB_SPIN_CAP (1u << 18)
#define LAS3 __attribute__((address_space(3)))
__device__ __forceinline__ unsigned xb_ld(unsigned* p)              { return __hip_atomic_load(p, __ATOMIC_RELAXED, __HIP_MEMORY_SCOPE_AGENT); }
__device__ __forceinline__ unsigned xb_add(unsigned* p, unsigned v) { return __hip_atomic_fetch_add(p, v, __ATOMIC_RELAXED, __HIP_MEMORY_SCOPE_AGENT); }
__device__ __forceinline__ unsigned xb_xcc_id() { return (unsigned)__builtin_amdgcn_s_getreg((3 << 11) | 20) & 0xFu; }
#define XB_SPIN(cond, bar) do { unsigned _sp = 0; while (cond) { __builtin_amdgcn_s_sleep(1); \
    if ((++_sp & 255u) == 0u) { if (xb_ld(&(bar)[XB_TMO])) break; if (_sp > XB_SPIN_CAP) { atomicAdd(&(bar)[XB_TMO], 1u); break; } } } } while (0)
struct XcdBarrier { unsigned* bar; unsigned x; volatile LAS3 unsigned* st; };
__device__ __forceinline__ XcdBarrier xcd_barrier_post(unsigned* bar, volatile LAS3 unsigned* st) {
    XcdBarrier b; b.bar = bar; b.x = xb_xcc_id(); b.st = st;
    if (threadIdx.x == 0) (void)xb_add(&bar[XB_XCNT(b.x)], 1u);
    return b;
}
__device__ __forceinline__ void xcd_barrier_complete(unsigned* bar, unsigned x, unsigned& nloc, unsigned& nx) {
    const unsigned G = gridDim.x * gridDim.y * gridDim.z;
    unsigned sum, cnt, mine, sp = 0u;
    for (;;) {
        sum = 0u; cnt = 0u; mine = 0u;
#pragma unroll
        for (unsigned j = 0; j < 16; ++j) { const unsigned c = xb_ld(&bar[XB_XCNT(j)]); sum += c; cnt += (c > 0u) ? 1u : 0u; mine = (j == x) ? c : mine; }
        if (sum == G) break;
        __builtin_amdgcn_s_sleep(1);
        if ((++sp & 255u) == 0u) { if (xb_ld(&bar[XB_TMO])) break; if (sp > XB_SPIN_CAP) { atomicAdd(&bar[XB_TMO], 1u); break; } }
    }
    nloc = mine > 0u ? mine : 1u; nx = cnt > 0u ? cnt : 1u;
}
__device__ __forceinline__ void xcd_barrier(const XcdBarrier& b) {
    asm volatile("s_waitcnt vmcnt(0)" ::: "memory");
    __syncthreads();
    if (threadIdx.x == 0) {
        unsigned* bar = b.bar;
        __builtin_amdgcn_s_waitcnt(0);
        unsigned nloc = b.st[0], nx = b.st[1];
        if (nloc == 0u) { xcd_barrier_complete(bar, b.x, nloc, nx); b.st[0] = nloc; b.st[1] = nx; }
        const unsigned old = xb_add(&bar[XB_XSUB(b.x)], 1u);
        const unsigned gen = old / nloc;
        if (old + 1u == (gen + 1u) * nloc) {
            __builtin_amdgcn_fence(__ATOMIC_RELEASE, "agent");
            asm volatile("s_waitcnt vmcnt(0)" ::: "memory");
            const unsigned og = xb_add(&bar[XB_TOP], 1u);
            const unsigned tg = og / nx;
            if (og + 1u == (tg + 1u) * nx) xb_add(&bar[XB_TOPGEN], 1u);
            else XB_SPIN(xb_ld(&bar[XB_TOPGEN]) == tg, bar);
            __builtin_amdgcn_fence(__ATOMIC_ACQUIRE, "agent");
            xb_add(&bar[XB_XGEN(b.x)], 1u);
            asm volatile("s_waitcnt vmcnt(0)" ::: "memory");
        } else {
            XB_SPIN(xb_ld(&bar[XB_XGEN(b.x)]) == gen, bar);
            __builtin_amdgcn_fence(__ATOMIC_ACQUIRE, "agent");
            asm volatile("s_waitcnt vmcnt(0)" ::: "memory");
        }
    }
    __syncthreads();
}

constexpr int NPHASE = 32;
#ifndef PHMASK
#define PHMASK 0xFFFFFFFFu
#endif
#define PHEN(n) ((PHMASK >> (n)) & 1u)

enum { K_P0 = 0, K_NORMMOD, K_FFN_UP, K_FFN_DOWN, K_E1, K_M1, K_M2, K_M3, K_UQKV, K_POST, K_ATTN, K_WOUT, K_O1, K_CONV, K_LRU, K_SCAN1, K_SCAN2 };
struct PhDesc { unsigned char kind, a0, a1, pad; };
__device__ const PhDesc PHTAB[NPHASE] = {
  {K_P0, 0, 0, 0}, {K_NORMMOD, 0, 0, 1}, {K_FFN_UP, 0, 0, 0}, {K_FFN_DOWN, 0, 1, 1}, {K_NORMMOD, 0, 1, 0}, {K_E1, 0, 0, 0}, {K_M1, 0, 0, 0}, {K_M2, 0, 0, 0},
  {K_M3, 0, 0, 0}, {K_UQKV, 0, 0, 0}, {K_POST, 0, 0, 0}, {K_ATTN, 0, 0, 0}, {K_WOUT, 0, 1, 0}, {K_NORMMOD, 0, 2, 0}, {K_FFN_UP, 1, 0, 0}, {K_FFN_DOWN, 1, 1, 0},
  {K_NORMMOD, 1, 0, 0}, {K_FFN_UP, 2, 0, 0}, {K_FFN_DOWN, 2, 1, 0}, {K_NORMMOD, 1, 1, 0}, {K_O1, 0, 0, 0}, {K_CONV, 0, 0, 0}, {K_LRU, 0, 0, 0}, {K_SCAN1, 0, 0, 0},
  {K_SCAN2, 0, 0, 0}, {K_LRU, 1, 0, 0}, {K_SCAN1, 1, 0, 0}, {K_SCAN2, 1, 0, 0}, {K_WOUT, 1, 0, 0}, {K_NORMMOD, 1, 2, 0}, {K_FFN_UP, 3, 1, 0}, {K_FFN_DOWN, 3, 0, 0}};
#ifndef KMASK
#define KMASK 0xFFFFFFFFu
#endif
#define KEN(k) ((KMASK >> (k)) & 1u)

__device__ __forceinline__ void run_phase(const Params& p, int ph, char* smem) {
  EpiArgs ea{};
  FEpi fe{};
  const int kind = PHTAB[ph].kind, a0 = PHTAB[ph].a0, a1 = PHTAB[ph].a1, a2 = PHTAB[ph].pad;
  switch (kind) {
    case K_P0: if (!KEN(K_P0)) break; p0_phase(p, smem); break;
    case K_NORMMOD: if (!KEN(K_NORMMOD)) break; normmod_phase(p, a0, a1, a2); break;
    case K_FFN_UP: if (!KEN(K_FFN_UP)) break;
      fe.outb = p.ACT(); fe.ldo = DFF;
      fast_gemm<EPI_SWIGLU>(p, fe, p.H(), D, p.Wgu(a0), D, 22, a1, smem); break;
    case K_FFN_DOWN: if (!KEN(K_FFN_DOWN)) break;
      fe.layer = a0 >> 1; fe.slot = (a0 & 1) ? 8 : 2; fe.scale = 0.5f; fe.xin = a2 ? p.x : nullptr;
      fast_gemm<EPI_RESID>(p, fe, p.ACT(), DFF, p.Wd(a0), DFF, 4, 1, smem);
      if (a1) ctx_gemm<EPI_RESID>(p, fe, p.ACT(), DFF, p.Wd(a0), DFF, 0, 16, smem);
      break;
    case K_E1: if (!KEN(K_E1)) break; fe.outb = p.ACT(); fe.outf = p.G();
      fast_gemm<EPI_E1>(p, fe, p.H(), D, p.Wein(), D, 11, 0, smem); break;
    case K_M1: if (!KEN(K_M1)) break; m1_phase(p, smem); break;
    case K_M2: if (!KEN(K_M2)) break; m2_phase(p); break;
    case K_M3: if (!KEN(K_M3)) break; m3_phase(p, smem); break;
    case K_UQKV: if (!KEN(K_UQKV)) break;
      for (int q = 0; q < 2; ++q) {
        fe.outb = q ? p.R() + (size_t)NTOK * 768 : p.R(); fe.ldo = q ? 1024 : 768; fe.rs = p.RS() + q;
        fast_gemm<EPI_ROWSCALE>(p, fe, p.ACT() + (q ? 384 : 0), PW, q ? p.Wukv() : p.Wuq(), q ? 256 : 384, q ? 4 : 3, 0, smem);
      }
      break;
    case K_POST: if (!KEN(K_POST)) break; post_phase(p); break;
    case K_ATTN: if (!KEN(K_ATTN)) break; attn_phase(p, smem); break;
    case K_WOUT: if (!KEN(K_WOUT)) break; fe.layer = a0; fe.slot = 5; fe.scale = 1.0f;
      fast_gemm<EPI_RESID>(p, fe, p.H(), D, a0 ? p.Woout() : p.Weout(), D, 4, 1, smem);
      if (a1) ctx_gemm<EPI_RESID>(p, fe, p.H(), D, a0 ? p.Woout() : p.Weout(), D, 0, 16, smem);
      break;
    case K_O1: if (!KEN(K_O1)) break; fe.outb = p.ACT(); fe.ldo = 2048;
      fast_gemm<EPI_PLAIN>(p, fe, p.H(), D, p.Woin(), D, 8, 1, smem);
      ctx_gemm<EPI_PLAIN>(p, fe, p.H(), D, p.Woin(), D, 1024, 16, smem); break;
    case K_CONV: if (!KEN(K_CONV)) break; conv_phase(p); break;
    case K_LRU: if (!KEN(K_LRU)) break; ea.dir = a0; ea.outu = (uint32_t*)p.R();
      gemm_phase<EPI_LRU>(p, ea, p.XC(), D, p.Wlru(a0), 128, NTOK / 256, 16, 1, 0, smem); break;
    case K_SCAN1: if (!KEN(K_SCAN1)) break; scan1_phase(p, a0); break;
    case K_SCAN2: if (!KEN(K_SCAN2)) break; scan2_phase(p, a0, smem); break;
    default: break;
  }
}

__global__ void __launch_bounds__(NTHR) mega(Params p, int ph_lo, int ph_hi) {
  extern __shared__ __attribute__((aligned(16))) char smem[];
  cg::grid_group grid = cg::this_grid();
  volatile LAS3 unsigned* st = (volatile LAS3 unsigned*)((LAS3 unsigned char*)smem + SMEM_BYTES - 16);
  if (threadIdx.x == 0) { st[0] = 0u; st[1] = 0u; }
  if (blockIdx.x == 0) { for (int i = threadIdx.x; i < XCD_BAR_WORDS; i += NTHR) p.bar()[i] = 0u; if (threadIdx.x < 32) p.kmax2()[threadIdx.x] = 0u; }
  __syncthreads();
  XcdBarrier xb; xb.bar = p.bar(); xb.x = xb_xcc_id(); xb.st = st;
#pragma unroll 1
  for (int ph = 0; ph < ph_hi; ++ph) {
    {
      const __attribute__((address_space(4))) char* ka = (const __attribute__((address_space(4))) char*)__builtin_amdgcn_kernarg_segment_ptr();
      asm volatile("" : "+s"(ka));
      const Params& pk = *(const Params*)ka;
      run_phase(pk, ph, smem);
    }
    if (ph + 1 < ph_hi) {
      if (ph == 0) {
        grid.sync();
        if (threadIdx.x == 0) (void)xb_add(&xb.bar[XB_XCNT(xb.x)], 1u);
      } else xcd_barrier(xb);
    }
  }
}

extern "C" void kernel_launch(void* const* d_in, const int* in_sizes, int n_in, void* d_out, int out_size, void* d_ws,
                              size_t ws_size, hipStream_t stream) {
  static int grid_blocks = 0;
  if (grid_blocks == 0) {
    int dev = 0, cus = 0, per_cu = 0;
    hipGetDevice(&dev);
    hipDeviceGetAttribute(&cus, hipDeviceAttributeMultiprocessorCount, dev);
    if (hipFuncSetAttribute((const void*)mega, hipFuncAttributeMaxDynamicSharedMemorySize, SMEM_BYTES) != hipSuccess) {
      fprintf(stderr, "hipFuncSetAttribute failed\n"); grid_blocks = -1; return;
    }
    if (hipOccupancyMaxActiveBlocksPerMultiprocessor(&per_cu, (const void*)mega, NTHR, SMEM_BYTES) != hipSuccess || per_cu < 1) {
      fprintf(stderr, "occupancy query failed (%d)\n", per_cu); grid_blocks = -1; return;
    }
    grid_blocks = cus;
    grid_blocks -= grid_blocks % 8;
  }
  if (grid_blocks < 0) return;

  Params p{};
  const float** ins = (const float**)&p.x;
  for (int i = 0; i < 29; ++i) ins[i] = (const float*)d_in[i];
  p.out = (float*)d_out;
  p.ws = (char*)d_ws;
  if (WS_TOTAL > ws_size) { fprintf(stderr, "workspace too small: need %zu have %zu\n", (size_t)WS_TOTAL, ws_size); return; }

  int lo = 0, hi = NPHASE;
  void* args[] = {&p, &lo, &hi};
  hipError_t e = hipLaunchCooperativeKernel((const void*)mega, dim3(grid_blocks), dim3(NTHR), args, SMEM_BYTES, stream);
  if (e != hipSuccess) fprintf(stderr, "cooperative launch failed: %s (grid %d)\n", hipGetErrorString(e), grid_blocks);
}
```

```cpp
#include <hip/hip_runtime.h>
#include <hip/hip_cooperative_groups.h>
#include <stdint.h>
#include <stdio.h>
namespace cg = cooperative_groups;

typedef unsigned short bf16_t;
typedef __attribute__((ext_vector_type(8))) short bf16x8;
typedef __attribute__((ext_vector_type(4))) float f32x4;

constexpr int D = 1024;
constexpr int SEQ = 8192;
constexpr int CTX = 256;
constexpr int TPB = SEQ + CTX;
constexpr int NTOK = 2 * TPB;
constexpr int DFF = 2816;
constexpr int NMOD = 9 * D;
constexpr int PW = 2816;
constexpr int NCHUNK = TPB / 64;
constexpr int NCHAIN = 16;
constexpr int NTHR = 512;
constexpr int SMEM_BYTES = 140 * 1024;

struct WDesc {
  const float* src; bf16_t* dst; const float* kscale;
  int K, N, ntn, nkt, nb, mode, item_start, pad;
};
constexpr int NWD = 22;
constexpr int N_WITEMS = 5220;

constexpr size_t al256(size_t x) { return (x + 255) & ~(size_t)255; }
constexpr size_t WGU_B = (size_t)5632 * 1024 * 2, WDN_B = (size_t)1024 * 2816 * 2, FFN_STRIDE = WGU_B + WDN_B;
constexpr size_t OFF_FFN = 0;
constexpr size_t OFF_WEIN = OFF_FFN + 4 * FFN_STRIDE;
constexpr size_t OFF_WEOUT = OFF_WEIN + al256((size_t)2816 * 1024 * 2);
constexpr size_t OFF_WUQ = OFF_WEOUT + al256((size_t)1024 * 1024 * 2);
constexpr size_t OFF_WUKV = OFF_WUQ + al256((size_t)768 * 384 * 2);
constexpr size_t OFF_WOIN = OFF_WUKV + al256((size_t)1024 * 256 * 2);
constexpr size_t OFF_WOOUT = OFF_WOIN + al256((size_t)2048 * 1024 * 2);
constexpr size_t OFF_WLRU = OFF_WOOUT + al256((size_t)1024 * 1024 * 2);
constexpr size_t WLRU_B = (size_t)2048 * 128 * 2;
constexpr size_t OFF_H = OFF_WLRU + 2 * WLRU_B;
constexpr size_t OFF_ACT = OFF_H + al256((size_t)NTOK * 1024 * 2);
constexpr size_t OFF_R = OFF_ACT + al256((size_t)NTOK * 2816 * 2);
constexpr size_t OFF_CTXRES = OFF_R + al256((size_t)NCHAIN * NCHUNK * 16384 * 2);
constexpr size_t OFF_MOD = OFF_CTXRES + al256((size_t)2 * CTX * D * 4);
constexpr size_t OFF_G = OFF_MOD + al256((size_t)2 * 3 * NMOD * 4);
constexpr size_t OFF_RS = OFF_G + al256((size_t)NTOK * 16 * 4);
constexpr size_t OFF_KR = OFF_RS + al256((size_t)NTOK * 2 * 4);
constexpr size_t OFF_DN = OFF_KR + al256((size_t)NTOK * 32 * 2);
constexpr size_t OFF_NST = OFF_DN + al256((size_t)NCHAIN * NCHUNK * 128 * 4);
constexpr size_t OFF_MLOC = OFF_NST + al256((size_t)NCHAIN * NCHUNK * 128 * 4);
constexpr size_t OFF_BEND = OFF_MLOC + al256((size_t)NCHAIN * NCHUNK * 4);
constexpr size_t OFF_MST = OFF_BEND + al256((size_t)NCHAIN * NCHUNK * 4);
constexpr size_t OFF_BAR = OFF_MST + al256((size_t)NCHAIN * NCHUNK * 4);
constexpr size_t OFF_KMAX = OFF_BAR + al256((size_t)3456 * 4);
constexpr size_t OFF_ROPE = OFF_KMAX + 256;
constexpr size_t OFF_SUMA = OFF_ROPE + 128 * 8 * 8;
constexpr size_t OFF_SUMH = OFF_SUMA + al256((size_t)8 * 264 * 256 * 4);
constexpr size_t WS_TOTAL = OFF_SUMH + al256((size_t)8 * 264 * 256 * 4);

struct Params {
  const float *x, *c, *ctx, *c_ctx, *mod_w, *mod_b, *norm_g, *ffn_w_gate, *ffn_w_up, *ffn_w_down;
  const float *even_w_in, *even_w_out, *mla_cq_g, *mla_w_uq, *mla_ckv_g, *mla_w_ukv, *mla_q_g, *mla_k_g;
  const float *mlstm_gate_b, *mlstm_out_g, *odd_w_in, *odd_conv_w, *odd_conv_b;
  const float *lru_w_a, *lru_b_a, *lru_w_x, *lru_b_x, *lru_lam, *odd_w_out;
  float* out;
  char* ws;
  __host__ __device__ __forceinline__ char* wsl() const {
#if defined(__HIP_DEVICE_COMPILE__)
    return (char*)((__attribute__((address_space(1))) char*)ws);
#else
    return ws;
#endif
  }
  __host__ __device__ __forceinline__ float* ctxres() const { return (float*)(wsl() + OFF_CTXRES); }
  __host__ __device__ __forceinline__ float* mod() const { return (float*)(wsl() + OFF_MOD); }
  __host__ __device__ __forceinline__ float* G() const { return (float*)(wsl() + OFF_G); }
  __host__ __device__ __forceinline__ float* RS() const { return (float*)(wsl() + OFF_RS); }
  __host__ __device__ __forceinline__ bf16_t* KR() const { return (bf16_t*)(wsl() + OFF_KR); }
  __host__ __device__ __forceinline__ float* dn() const { return (float*)(wsl() + OFF_DN); }
  __host__ __device__ __forceinline__ float* nst() const { return (float*)(wsl() + OFF_NST); }
  __host__ __device__ __forceinline__ float* mloc() const { return (float*)(wsl() + OFF_MLOC); }
  __host__ __device__ __forceinline__ float* bend() const { return (float*)(wsl() + OFF_BEND); }
  __host__ __device__ __forceinline__ float* mst() const { return (float*)(wsl() + OFF_MST); }
  __host__ __device__ __forceinline__ bf16_t* Wgu(int i) const { return (bf16_t*)(wsl() + OFF_FFN + (size_t)i * FFN_STRIDE); }
  __host__ __device__ __forceinline__ bf16_t* Wd(int i) const { return (bf16_t*)(wsl() + OFF_FFN + (size_t)i * FFN_STRIDE + WGU_B); }
  __host__ __device__ __forceinline__ bf16_t* Wein() const { return (bf16_t*)(wsl() + OFF_WEIN); }
  __host__ __device__ __forceinline__ bf16_t* Weout() const { return (bf16_t*)(wsl() + OFF_WEOUT); }
  __host__ __device__ __forceinline__ bf16_t* Wuq() const { return (bf16_t*)(wsl() + OFF_WUQ); }
  __host__ __device__ __forceinline__ bf16_t* Wukv() const { return (bf16_t*)(wsl() + OFF_WUKV); }
  __host__ __device__ __forceinline__ bf16_t* Woin() const { return (bf16_t*)(wsl() + OFF_WOIN); }
  __host__ __device__ __forceinline__ bf16_t* Woout() const { return (bf16_t*)(wsl() + OFF_WOOUT); }
  __host__ __device__ __forceinline__ bf16_t* Wlru(int i) const { return (bf16_t*)(wsl() + OFF_WLRU + (size_t)i * WLRU_B); }
  __host__ __device__ __forceinline__ bf16_t* H() const { return (bf16_t*)(wsl() + OFF_H); }
  __host__ __device__ __forceinline__ bf16_t* ACT() const { return (bf16_t*)(wsl() + OFF_ACT); }
  __host__ __device__ __forceinline__ bf16_t* R() const { return (bf16_t*)(wsl() + OFF_R); }
  __host__ __device__ __forceinline__ bf16_t* XC() const { return (bf16_t*)(wsl() + OFF_FFN); }
  __host__ __device__ __forceinline__ unsigned* bar() const { return (unsigned*)(wsl() + OFF_BAR); }
  __host__ __device__ __forceinline__ float* SUMA() const { return (float*)(wsl() + OFF_SUMA); }
  __host__ __device__ __forceinline__ float* SUMH() const { return (float*)(wsl() + OFF_SUMH); }
  __host__ __device__ __forceinline__ float2* ropetab() const { return (float2*)(wsl() + OFF_ROPE); }
  __host__ __device__ __forceinline__ unsigned* kmax2() const { return (unsigned*)(wsl() + OFF_KMAX); }
};

__device__ __forceinline__ float bf2f(bf16_t h) { return __uint_as_float(((uint32_t)h) << 16); }
__device__ __forceinline__ bf16_t f2bf(float f) {
  uint32_t u = __float_as_uint(f);
  u += 0x7FFFu + ((u >> 16) & 1u);
  return (bf16_t)(u >> 16);
}
__device__ __forceinline__ uint32_t pack2(float a, float b) { uint32_t r; asm("v_cvt_pk_bf16_f32 %0, %1, %2" : "=v"(r) : "v"(a), "v"(b)); return r; }
__device__ __forceinline__ float lo2f(uint32_t u) { return __uint_as_float(u << 16); }
__device__ __forceinline__ float hi2f(uint32_t u) { return __uint_as_float(u & 0xFFFF0000u); }
__device__ __forceinline__ float sigmoidf_(float x) { return __builtin_amdgcn_rcpf(1.0f + __expf(-x)); }
__device__ __forceinline__ float siluf_(float x) { return x * __builtin_amdgcn_rcpf(1.0f + __expf(-x)); }
__device__ __forceinline__ float logsigmoidf_(float x) { return fminf(x, 0.0f) - log1pf(__expf(-fabsf(x))); }
__device__ __forceinline__ float gelu_tanh(float x) {
  float z = 0.7978845608028654f * (x + 0.044715f * x * x * x);
  float t = 1.0f - 2.0f / (1.0f + __expf(2.0f * z));
  return 0.5f * x * (1.0f + t);
}
__device__ __forceinline__ float* xrow(const Params& p, int r) {
  int b = r >= TPB ? 1 : 0; int u = r - b * TPB;
  return (u < CTX) ? p.ctxres() + (size_t)(b * CTX + u) * D : p.out + ((size_t)b * SEQ + (u - CTX)) * D;
}
__device__ __forceinline__ int condof(int r) { int b = r >= TPB ? 1 : 0; int u = r - b * TPB; return u < CTX ? 2 : b; }
__device__ __forceinline__ float wave_sum(float v) {
#pragma unroll
  for (int o = 32; o >= 1; o >>= 1) v += __shfl_xor(v, o);
  return v;
}
__device__ __forceinline__ float wave_max(float v) {
#pragma unroll
  for (int o = 32; o >= 1; o >>= 1) v = fmaxf(v, __shfl_xor(v, o));
  return v;
}
__device__ __forceinline__ int otid() { int t = threadIdx.x; asm volatile("" : "+v"(t)); return t; }
__device__ __forceinline__ int obid() { int t = blockIdx.x; asm volatile("" : "+s"(t)); return t; }
__device__ const float ROPE_INV[8] = {1.0f, 0.316227766016838f, 0.1f, 0.0316227766016838f, 0.01f, 0.00316227766016838f, 0.001f, 0.000316227766016838f};
#define MFMA16(a, b, c) __builtin_amdgcn_mfma_f32_16x16x32_bf16(a, b, c, 0, 0, 0)


__device__ __forceinline__ WDesc get_wdesc(const Params& p, int wi) {
  WDesc d; d.kscale = nullptr; d.nb = 1; d.pad = 0;
  if (wi < 4224) {
    int di = wi / 352, lf = di / 3, kind = di - lf * 3;
    d.item_start = di * 352;
    if (kind == 0) { d.src = p.ffn_w_gate + (size_t)lf * 1024 * 2816; d.dst = p.Wgu(lf); d.K = 1024; d.N = 2816; d.ntn = 44; d.nkt = 8; d.mode = 1; }
    else if (kind == 1) { d.src = p.ffn_w_up + (size_t)lf * 1024 * 2816; d.dst = p.Wgu(lf); d.K = 1024; d.N = 2816; d.ntn = 44; d.nkt = 8; d.mode = 2; }
    else { d.src = p.ffn_w_down + (size_t)lf * 2816 * 1024; d.dst = p.Wd(lf); d.K = 2816; d.N = 1024; d.ntn = 16; d.nkt = 22; d.mode = 0; }
  } else if (wi < 4576) { d.src = p.even_w_in; d.dst = p.Wein(); d.K = 1024; d.N = 2736; d.ntn = 44; d.nkt = 8; d.mode = 0; d.item_start = 4224; }
  else if (wi < 4704) { d.src = p.even_w_out; d.dst = p.Weout(); d.K = 1024; d.N = 1024; d.ntn = 16; d.nkt = 8; d.mode = 0; d.item_start = 4576; }
  else if (wi < 4740) { d.src = p.mla_w_uq; d.dst = p.Wuq(); d.kscale = p.mla_cq_g; d.K = 384; d.N = 768; d.ntn = 12; d.nkt = 3; d.mode = 0; d.item_start = 4704; }
  else if (wi < 4772) { d.src = p.mla_w_ukv; d.dst = p.Wukv(); d.kscale = p.mla_ckv_g; d.K = 256; d.N = 1024; d.ntn = 16; d.nkt = 2; d.mode = 0; d.item_start = 4740; }
  else if (wi < 5028) { d.src = p.odd_w_in; d.dst = p.Woin(); d.K = 1024; d.N = 2048; d.ntn = 32; d.nkt = 8; d.mode = 0; d.item_start = 4772; }
  else if (wi < 5156) { d.src = p.odd_w_out; d.dst = p.Woout(); d.K = 1024; d.N = 1024; d.ntn = 16; d.nkt = 8; d.mode = 0; d.item_start = 5028; }
  else {
    int q = (wi - 5156) >> 4, dir = q >> 1, gx = q & 1;
    d.src = (gx ? p.lru_w_x : p.lru_w_a) + (size_t)dir * 8 * 128 * 128; d.dst = p.Wlru(dir);
    d.K = 128; d.N = 128; d.ntn = 2; d.nkt = 1; d.nb = 8; d.mode = 1 + gx; d.item_start = 5156 + q * 16;
  }
  return d;
}

__device__ __forceinline__ void wload(const WDesc& d, int wi, int tid, float4 (&v)[4]) {
  int local = wi - d.item_start;
  int tiles = d.ntn * d.nkt;
  int bi = local / tiles, rem = local - bi * tiles;
  int kt = rem / d.ntn, nt = rem - kt * d.ntn;
  const float* src = d.src + (size_t)bi * d.K * d.N;
  int k0 = kt * 128, n0 = nt * 64;
#pragma unroll
  for (int i = 0; i < 4; ++i) {
    int idx = tid + i * NTHR;
    int k = idx >> 4, n4 = (idx & 15) * 4;
    v[i] = make_float4(0, 0, 0, 0);
    if (n0 + n4 < d.N) v[i] = *(const float4*)(src + (size_t)(k0 + k) * d.N + n0 + n4);
    if (d.kscale) { float g = d.kscale[k0 + k]; v[i].x *= g; v[i].y *= g; v[i].z *= g; v[i].w *= g; }
  }
}
__device__ __forceinline__ int wsw(int n, int k) { return n * 136 + ((((k >> 3) ^ (n >> 2)) & 15) << 3) + (k & 7); }
__device__ __forceinline__ void wstore(const WDesc& d, int wi, int tid, const float4 (&v)[4], bf16_t* s) {
  int local = wi - d.item_start;
  int tiles = d.ntn * d.nkt;
  int bi = local / tiles, rem = local - bi * tiles;
  int kt = rem / d.ntn, nt = rem - kt * d.ntn;
  int k0 = kt * 128, n0 = nt * 64;
#pragma unroll
  for (int i = 0; i < 4; ++i) {
    int idx = tid + i * NTHR;
    int k = idx >> 4, n4 = (idx & 15) * 4;
    s[wsw(n4 + 0, k)] = f2bf(v[i].x);
    s[wsw(n4 + 1, k)] = f2bf(v[i].y);
    s[wsw(n4 + 2, k)] = f2bf(v[i].z);
    s[wsw(n4 + 3, k)] = f2bf(v[i].w);
  }
  __syncthreads();
#pragma unroll
  for (int i = 0; i < 2; ++i) {
    int idx = tid + i * NTHR;
    int n = idx >> 4, kc = (idx & 15) * 8;
    int gidx = bi * d.N + n0 + n;
    int drow = gidx;
    if (d.mode != 0) drow = (gidx >> 6) * 128 + ((gidx & 63) >> 4) * 32 + (gidx & 15) + (d.mode == 2 ? 16 : 0);
    uint4 o = *(const uint4*)(s + wsw(n, kc));
    *(uint4*)(d.dst + (size_t)drow * d.K + k0 + kc) = o;
  }
  __syncthreads();
}

__device__ __forceinline__ void p0_phase(const Params& p, char* smem) {
  const int tid = otid();
  const int G = gridDim.x, bid = obid();
  for (int it = bid; it < 144; it += G) {
    int layer = it / 72, cgp = it % 72;
    float* sc = (float*)smem;
    float* red = sc + 3 * 1024;
    for (int i = tid; i < 3 * 1024; i += NTHR) {
      int r = i >> 10, k = i & 1023;
      float v = (r < 2) ? p.c[r * 1024 + k] : p.c_ctx[k];
      sc[i] = siluf_(v);
    }
    __syncthreads();
    int ksl = tid >> 5, l32 = tid & 31;
    int col = cgp * 128 + l32 * 4;
    float a0[4] = {0, 0, 0, 0}, a1[4] = {0, 0, 0, 0}, a2[4] = {0, 0, 0, 0};
    const float* wp = p.mod_w + ((size_t)layer * 1024 + ksl * 64) * NMOD + col;
#pragma unroll 16
    for (int k = 0; k < 64; ++k) {
      float4 wv = *(const float4*)(wp + (size_t)k * NMOD);
      float s0 = sc[ksl * 64 + k], s1 = sc[1024 + ksl * 64 + k], s2 = sc[2048 + ksl * 64 + k];
      a0[0] += s0 * wv.x; a0[1] += s0 * wv.y; a0[2] += s0 * wv.z; a0[3] += s0 * wv.w;
      a1[0] += s1 * wv.x; a1[1] += s1 * wv.y; a1[2] += s1 * wv.z; a1[3] += s1 * wv.w;
      a2[0] += s2 * wv.x; a2[1] += s2 * wv.y; a2[2] += s2 * wv.z; a2[3] += s2 * wv.w;
    }
#pragma unroll
    for (int q = 0; q < 4; ++q) {
      red[(ksl * 3 + 0) * 128 + l32 * 4 + q] = a0[q];
      red[(ksl * 3 + 1) * 128 + l32 * 4 + q] = a1[q];
      red[(ksl * 3 + 2) * 128 + l32 * 4 + q] = a2[q];
    }
    __syncthreads();
    if (tid < 384) {
      int r = tid >> 7, cc = tid & 127;
      float sum = 0;
#pragma unroll
      for (int ww = 0; ww < 16; ++ww) sum += red[(ww * 3 + r) * 128 + cc];
      int gc = cgp * 128 + cc;
      p.mod()[((size_t)layer * 3 + r) * NMOD + gc] = sum + p.mod_b[layer * NMOD + gc];
    }
    __syncthreads();
  }
  {
    bf16_t* s = (bf16_t*)smem;
    int wi = (bid + G - (144 % G)) % G;
    float4 v[4], vn[4];
    WDesc d = get_wdesc(p, wi < N_WITEMS ? wi : 0);
    if (wi < N_WITEMS) wload(d, wi, tid, v);
    while (wi < N_WITEMS) {
      int win = wi + G;
      WDesc dn = get_wdesc(p, win < N_WITEMS ? win : 0);
      if (win < N_WITEMS) wload(dn, win, tid, vn);
      wstore(d, wi, tid, v, s);
#pragma unroll
      for (int i = 0; i < 4; ++i) v[i] = vn[i];
      d = dn; wi = win;
    }
  }
  for (int i = bid * NTHR + tid; i < 1024; i += G * NTHR) {
    float ang = (float)(i >> 3) * ROPE_INV[i & 7];
    p.ropetab()[i] = make_float2(cosf(ang), sinf(ang));
  }
  for (int i = bid * NTHR + tid; i < 2 * CTX * D / 4; i += G * NTHR) ((float4*)p.ctxres())[i] = ((const float4*)p.ctx)[i];
}

__device__ __forceinline__ void normmod_phase(const Params& p, int layer, int which, int first) {
  const int tid_ = otid();
  const int lane = tid_ & 63, w = tid_ >> 6;
  const float* g = p.norm_g + (layer * 3 + which) * D;
  const int stride = gridDim.x * 8;
  const float* xlat = first ? p.x : p.out;
  for (int row0 = obid() * 8 + w; row0 < NTOK; row0 += 2 * stride) {
    float4 v[2][4];
    bool ok[2];
#pragma unroll
    for (int q = 0; q < 2; ++q) {
      int row = row0 + q * stride;
      ok[q] = row < NTOK;
      if (ok[q]) {
        int b = row >= TPB ? 1 : 0, u = row - b * TPB;
        const float* x = (u < CTX) ? p.ctxres() + (size_t)(b * CTX + u) * D : xlat + ((size_t)b * SEQ + (u - CTX)) * D;
#pragma unroll
        for (int i = 0; i < 4; ++i) v[q][i] = *(const float4*)(x + i * 256 + lane * 4);
      }
    }
#pragma unroll
    for (int q = 0; q < 2; ++q) {
      if (!ok[q]) continue;
      int row = row0 + q * stride;
      const float* md = p.mod() + ((size_t)layer * 3 + condof(row)) * NMOD + which * 3 * D;
      float ss = 0;
#pragma unroll
      for (int i = 0; i < 4; ++i) ss += v[q][i].x * v[q][i].x + v[q][i].y * v[q][i].y + v[q][i].z * v[q][i].z + v[q][i].w * v[q][i].w;
      ss = wave_sum(ss);
      float rstd = rsqrtf(ss * (1.0f / D) + 1e-6f);
#pragma unroll
      for (int i = 0; i < 4; ++i) {
        int cidx = i * 256 + lane * 4;
        float4 g4 = *(const float4*)(g + cidx);
        float4 sh = *(const float4*)(md + cidx);
        float4 sc = *(const float4*)(md + D + cidx);
        float h0 = v[q][i].x * rstd * g4.x * (1.0f + sc.x) + sh.x;
        float h1 = v[q][i].y * rstd * g4.y * (1.0f + sc.y) + sh.y;
        float h2 = v[q][i].z * rstd * g4.z * (1.0f + sc.z) + sh.z;
        float h3 = v[q][i].w * rstd * g4.w * (1.0f + sc.w) + sh.w;
        uint2 o; o.x = pack2(h0, h1); o.y = pack2(h2, h3);
        *(uint2*)(p.H() + (size_t)row * D + cidx) = o;
      }
    }
  }
}

enum { EPI_SWIGLU = 1, EPI_RESID = 2, EPI_E1 = 3, EPI_ROWSCALE = 4, EPI_PLAIN = 5, EPI_LRU = 6 };
struct EpiArgs {
  bf16_t* outb; int ldo; int slot; float scale; int layer; int dir;
  float* outf; const float* rs; uint32_t* outu;
};
constexpr int LDT = 72;

template <int EPI>
__device__ __forceinline__ void gemm_tile(const Params& p, const EpiArgs& ea, const bf16_t* __restrict__ A, int lda,
                                          const bf16_t* __restrict__ Bt, int K, int m0, int n0, char* smem) {
  bf16_t* sA = (bf16_t*)smem;
  bf16_t* sB = sA + 2 * 256 * LDT;
  const int tid = otid(), lane = tid & 63, w = tid >> 6, wm = w & 3, wn = w >> 2, fr = lane & 15, fq = lane >> 4;
  f32x4 acc[4][4];
#pragma unroll
  for (int i = 0; i < 4; ++i)
#pragma unroll
    for (int j = 0; j < 4; ++j) acc[i][j] = (f32x4){0.f, 0.f, 0.f, 0.f};
  const int srow = tid >> 3, sch = (tid & 7) * 8;
  const bf16_t* ap = A + (size_t)(m0 + srow) * lda + sch;
  const bf16_t* bp = Bt + (size_t)(n0 + srow) * K + sch;
  const size_t a_step = (size_t)64 * lda, b_step = (size_t)64 * K;
  uint4 ra[4], rb[2];
  const int nk = K >> 6;
#pragma unroll
  for (int i = 0; i < 4; ++i) ra[i] = *(const uint4*)(ap + i * a_step);
#pragma unroll
  for (int i = 0; i < 2; ++i) rb[i] = *(const uint4*)(bp + i * b_step);
#pragma unroll
  for (int i = 0; i < 4; ++i) *(uint4*)(sA + (srow + i * 64) * LDT + sch) = ra[i];
#pragma unroll
  for (int i = 0; i < 2; ++i) *(uint4*)(sB + (srow + i * 64) * LDT + sch) = rb[i];
  __syncthreads();
  for (int kt = 0; kt < nk; ++kt) {
    const int buf = kt & 1;
    if (kt + 1 < nk) {
#pragma unroll
      for (int i = 0; i < 4; ++i) ra[i] = *(const uint4*)(ap + i * a_step + (kt + 1) * 64);
#pragma unroll
      for (int i = 0; i < 2; ++i) rb[i] = *(const uint4*)(bp + i * b_step + (kt + 1) * 64);
    }
    const bf16_t* cA = sA + buf * 256 * LDT + (wm * 64 + fr) * LDT + fq * 8;
    const bf16_t* cB = sB + buf * 128 * LDT + (wn * 64 + fr) * LDT + fq * 8;
#pragma unroll
    for (int ks = 0; ks < 2; ++ks) {
      bf16x8 af[4], bfg[4];
#pragma unroll
      for (int mi = 0; mi < 4; ++mi) af[mi] = *(const bf16x8*)(cA + mi * 16 * LDT + ks * 32);
#pragma unroll
      for (int ni = 0; ni < 4; ++ni) bfg[ni] = *(const bf16x8*)(cB + ni * 16 * LDT + ks * 32);
#pragma unroll
      for (int mi = 0; mi < 4; ++mi)
#pragma unroll
        for (int ni = 0; ni < 4; ++ni) acc[mi][ni] = MFMA16(af[mi], bfg[ni], acc[mi][ni]);
    }
    if (kt + 1 < nk) {
      bf16_t* dA = sA + (buf ^ 1) * 256 * LDT;
      bf16_t* dB = sB + (buf ^ 1) * 128 * LDT;
#pragma unroll
      for (int i = 0; i < 4; ++i) *(uint4*)(dA + (srow + i * 64) * LDT + sch) = ra[i];
#pragma unroll
      for (int i = 0; i < 2; ++i) *(uint4*)(dB + (srow + i * 64) * LDT + sch) = rb[i];
    }
    __syncthreads();
  }
#pragma unroll
  for (int mi = 0; mi < 4; ++mi) {
    const int r0 = m0 + wm * 64 + mi * 16 + fq * 4;
    if (EPI == EPI_SWIGLU) {
#pragma unroll
      for (int nh = 0; nh < 2; ++nh) {
        int hc = (n0 >> 1) + wn * 32 + nh * 16 + fr;
#pragma unroll
        for (int j = 0; j < 4; ++j) {
          float g = acc[mi][nh * 2][j], u = acc[mi][nh * 2 + 1][j];
          ea.outb[(size_t)(r0 + j) * ea.ldo + hc] = f2bf(siluf_(g) * u);
        }
      }
    } else if (EPI == EPI_RESID) {
      float* xb = xrow(p, r0);
      const float* md = p.mod() + ((size_t)ea.layer * 3 + condof(r0)) * NMOD + ea.slot * D;
#pragma unroll
      for (int ni = 0; ni < 4; ++ni) {
        int cc = n0 + wn * 64 + ni * 16 + fr;
        float gs = md[cc] * ea.scale;
#pragma unroll
        for (int j = 0; j < 4; ++j) {
          float* px = xb + (size_t)j * D + cc;
          *px = *px + gs * acc[mi][ni][j];
        }
      }
    } else if (EPI == EPI_E1) {
#pragma unroll
      for (int ni = 0; ni < 4; ++ni) {
        int cc = n0 + wn * 64 + ni * 16 + fr;
        float sc = (cc >= 1184 && cc < 1696) ? 0.08838834764831845f : 1.0f;
#pragma unroll
        for (int j = 0; j < 4; ++j) {
          float v = acc[mi][ni][j];
          ea.outb[(size_t)(r0 + j) * PW + cc] = f2bf(v * sc);
          if (cc >= 2720 && cc < 2736) ea.outf[(size_t)(r0 + j) * 16 + (cc - 2720)] = v;
        }
      }
    } else if (EPI == EPI_ROWSCALE) {
#pragma unroll
      for (int j = 0; j < 4; ++j) {
        float rs = ea.rs[(size_t)(r0 + j) * 2];
#pragma unroll
        for (int ni = 0; ni < 4; ++ni) {
          int cc = n0 + wn * 64 + ni * 16 + fr;
          ea.outb[(size_t)(r0 + j) * ea.ldo + cc] = f2bf(acc[mi][ni][j] * rs);
        }
      }
    } else if (EPI == EPI_PLAIN) {
#pragma unroll
      for (int ni = 0; ni < 4; ++ni) {
        int cc = n0 + wn * 64 + ni * 16 + fr;
#pragma unroll
        for (int j = 0; j < 4; ++j) ea.outb[(size_t)(r0 + j) * ea.ldo + cc] = f2bf(acc[mi][ni][j]);
      }
    } else if (EPI == EPI_LRU) {
#pragma unroll
      for (int nh = 0; nh < 2; ++nh) {
        int ch = (n0 >> 1) + wn * 32 + nh * 16 + fr;
        float ba = p.lru_b_a[ea.dir * 1024 + ch], bx = p.lru_b_x[ea.dir * 1024 + ch];
        float sp8 = -8.0f * log1pf(__expf(-p.lru_lam[ea.dir * 1024 + ch]));
#pragma unroll
        for (int j = 0; j < 4; ++j) {
          float r = sigmoidf_(acc[mi][nh * 2][j] + ba);
          float ig = sigmoidf_(acc[mi][nh * 2 + 1][j] + bx);
          float la = r * sp8;
          float x2 = 2.0f * la;
          float poly = -x2 * (1.0f + x2 * (0.5f + x2 * (0.16666667f + x2 * (0.041666668f + x2 * (0.008333334f + x2 * 0.0013888889f)))));
          float em = (x2 < -0.3f) ? (1.0f - __expf(x2)) : poly;
          float u = bf2f(p.XC()[(size_t)(r0 + j) * D + ch]);
          float inp = __builtin_amdgcn_sqrtf(fmaxf(em, 0.0f)) * (ig * u);
          ea.outu[(size_t)(r0 + j) * D + ch] = pack2(la, inp);
        }
      }
    }
  }
}

namespace pg8 {
#define PG8_LAS __attribute__((address_space(3)))
typedef unsigned u32x4 __attribute__((ext_vector_type(4)));
constexpr int BM = 256, BK = 64, HALF = 128, HTB = HALF * BK * 2, STAGE_BYTES = 8 * HTB, NXCD = 8, WGM = 8;
__device__ __forceinline__ int lds_byte(int r, int c) { const int st = (r >> 4) * 2 + (c >> 5), rr = r & 15, cc = c & 31, ob = rr * 64 + cc * 2; return st * 1024 + (ob ^ (((ob >> 9) & 1) << 5)); }
__device__ __forceinline__ void stage_rc(int b, int& R, int& C) { const int st = b / 1024, sb = b % 1024, swz = sb ^ (((sb >> 9) & 1) << 5); R = (st >> 1) * 16 + swz / 64; C = (st & 1) * 32 + (swz % 64) / 2; }
struct Unit { int pm, pn; };
struct Gemm { const bf16_t* A; int lda; const bf16_t* Bt; int K; };
struct Sched {
  int nM, nN, nwg, G, c, latent;
  __device__ void init(int nM_, int nN_, int G_, int c_, int latent_) { nM = nM_; nN = nN_; nwg = nM * nN; G = G_; c = c_; latent = latent_; }
  __device__ bool next(int i, Unit& u) const {
    const long L = (long)i * G + c; if (L >= nwg) return false;
    int wgid = (int)L; { const int q = nwg / NXCD, r = nwg % NXCD, xcd = wgid % NXCD, off = wgid / NXCD; wgid = (xcd < r ? xcd * (q + 1) : r * (q + 1) + (xcd - r) * q) + off; }
    const int nig = WGM * nN, gid = wgid / nig, fm = gid * WGM, gsz = (nM - fm) < WGM ? (nM - fm) : WGM;
    int pm = fm + ((wgid % nig) % gsz); u.pn = (wgid % nig) / gsz;
    if (latent) pm = pm + 1 + (pm >= 32 ? 1 : 0);
    u.pm = pm; return true;
  }
};
template <class Epi>
__device__ __forceinline__ void gemm_phase(PG8_LAS unsigned char* lds, const Gemm g, const Sched& S, const Epi& E) {
    const int tid = otid(), wid = __builtin_amdgcn_readfirstlane(tid >> 6), lane = tid & 63, wr = wid >> 2, wc = wid & 3, fr = lane & 15, fq = lane >> 4;
    const int K = g.K, nt = K / BK, lda = g.lda;
    unsigned voffA[2], voffB[2];
#pragma unroll
    for (int i = 0; i < 2; ++i) { int R, C; stage_rc(tid * 16 + i * 8192, R, C);
        voffA[i] = (unsigned)(R * lda + C) * 2u; voffB[i] = (unsigned)(R * K + C) * 2u; }
    const size_t kstep = (size_t)(BK * 2);
    const size_t hsA = (size_t)HALF * lda * 2, hsB = (size_t)HALF * K * 2;
    const size_t tsA = 2 * hsA, tsB = 2 * hsB;
    const unsigned ldsw = (unsigned)wid * 1024u;
    const int aoff = lds_byte(wr * 64 + fr, fq * 8), boff = lds_byte(wc * 32 + fr, fq * 8);
#define PG8_SA(b, h) (((b) * 2 + (h)) * HTB)
#define PG8_SB(b, h) ((4 + (b) * 2 + (h)) * HTB)
#define PG8_STAGE(bufoff, gbase, voff) do { _Pragma("unroll") for (int _i = 0; _i < 2; ++_i) \
        __builtin_amdgcn_global_load_lds((const unsigned*)((const char*)(gbase) + (voff)[_i]), (PG8_LAS unsigned*)(lds + (bufoff) + ldsw + _i * 8192), 16, 0, 0); } while (0)
#define PG8_LDA(dst, b, h) do { _Pragma("unroll") for (int m = 0; m < 4; ++m) _Pragma("unroll") for (int k = 0; k < 2; ++k) dst[m][k] = *(const PG8_LAS bf16x8*)(lds + PG8_SA(b, h) + aoff + m * 2048 + k * 1024); } while (0)
#define PG8_LDB(dst, b, h) do { _Pragma("unroll") for (int n = 0; n < 2; ++n) _Pragma("unroll") for (int k = 0; k < 2; ++k) dst[n][k] = *(const PG8_LAS bf16x8*)(lds + PG8_SB(b, h) + boff + n * 2048 + k * 1024); } while (0)
#define PG8_MMA(ai, bj, At, Bt) do { __builtin_amdgcn_s_setprio(1); _Pragma("unroll") for (int m = 0; m < 4; ++m) _Pragma("unroll") for (int n = 0; n < 2; ++n) _Pragma("unroll") for (int k = 0; k < 2; ++k) \
        acc[ai][bj][m][n] = __builtin_amdgcn_mfma_f32_16x16x32_bf16(Bt[n][k], At[m][k], acc[ai][bj][m][n], 0, 0, 0); __builtin_amdgcn_s_setprio(0); } while (0)
#define PG8_WAIT_V(n) asm volatile("s_waitcnt vmcnt(" #n ")" ::: "memory")
#define PG8_WAIT_L(n) asm volatile("s_waitcnt lgkmcnt(" #n ")" ::: "memory")
#define PG8_BAR __builtin_amdgcn_s_barrier()
#define PG8_SCHED __builtin_amdgcn_sched_barrier(0)
    Unit cur, nxt; int ui = 0;
    if (!S.next(0, cur)) return;
    f32x4 acc[2][2][4][2];
#pragma unroll
    for (int a = 0; a < 2; ++a)
#pragma unroll
        for (int b = 0; b < 2; ++b)
#pragma unroll
            for (int m = 0; m < 4; ++m)
#pragma unroll
                for (int n = 0; n < 2; ++n) acc[a][b][m][n] = (f32x4){0.f, 0.f, 0.f, 0.f};
    bf16x8 At[4][2], B0[2][2], B1[2][2];
    const char* cA = (const char*)g.A + (size_t)cur.pm * tsA; const char* cB = (const char*)g.Bt + (size_t)cur.pn * tsB;
    PG8_STAGE(PG8_SB(0, 0), cB, voffB); PG8_STAGE(PG8_SA(0, 0), cA, voffA); PG8_STAGE(PG8_SB(0, 1), cB + hsB, voffB); PG8_STAGE(PG8_SA(0, 1), cA + hsA, voffA);
    if (wr == 1) PG8_BAR;
    PG8_WAIT_V(4); PG8_BAR;
    PG8_STAGE(PG8_SB(1, 0), cB + kstep, voffB); PG8_STAGE(PG8_SA(1, 0), cA + kstep, voffA); PG8_STAGE(PG8_SB(1, 1), cB + hsB + kstep, voffB);
    PG8_WAIT_V(6); PG8_BAR;
    for (;;) {
        const bool has_next = S.next(ui + 1, nxt);
        const char* nA = has_next ? (const char*)g.A + (size_t)nxt.pm * tsA : cA; const char* nB = has_next ? (const char*)g.Bt + (size_t)nxt.pn * tsB : cB;
        for (int t = 0; t < nt; t += 2) {
            const bool last = (t == nt - 2);
            const char* a1 = cA + (size_t)(t + 1) * kstep;
            const char* a2 = last ? nA : cA + (size_t)(t + 2) * kstep; const char* b2 = last ? nB : cB + (size_t)(t + 2) * kstep;
            const char* a3 = a2 + kstep; const char* b3 = b2 + kstep;
            PG8_LDB(B0, 0, 0); PG8_SCHED; PG8_LDA(At, 0, 0); PG8_STAGE(PG8_SA(1, 1), a1 + hsA, voffA);
            PG8_WAIT_L(8); PG8_BAR; PG8_WAIT_L(0); PG8_MMA(0, 0, At, B0); PG8_BAR; PG8_SCHED;
            PG8_LDB(B1, 0, 1); PG8_STAGE(PG8_SB(0, 0), b2, voffB);
            PG8_BAR; PG8_WAIT_L(0); PG8_MMA(0, 1, At, B1); PG8_BAR;
            PG8_LDA(At, 0, 1); PG8_STAGE(PG8_SA(0, 0), a2, voffA);
            PG8_BAR; PG8_WAIT_L(0); PG8_MMA(1, 0, At, B0); PG8_BAR; PG8_SCHED;
            PG8_STAGE(PG8_SB(0, 1), b2 + hsB, voffB);
            PG8_WAIT_V(6); PG8_BAR; PG8_MMA(1, 1, At, B1); PG8_BAR;
            PG8_LDB(B0, 1, 0); PG8_SCHED; PG8_LDA(At, 1, 0); PG8_STAGE(PG8_SA(0, 1), a2 + hsA, voffA);
            PG8_WAIT_L(8); PG8_BAR; PG8_WAIT_L(0); PG8_MMA(0, 0, At, B0); PG8_BAR; PG8_SCHED;
            PG8_LDB(B1, 1, 1); PG8_STAGE(PG8_SB(1, 0), b3, voffB);
            PG8_BAR; PG8_WAIT_L(0); PG8_MMA(0, 1, At, B1); PG8_BAR;
            PG8_LDA(At, 1, 1); PG8_STAGE(PG8_SA(1, 0), a3, voffA);
            PG8_BAR; PG8_WAIT_L(0); PG8_MMA(1, 0, At, B0); PG8_BAR; PG8_SCHED;
            PG8_STAGE(PG8_SB(1, 1), b3 + hsB, voffB);
            PG8_WAIT_V(6); PG8_BAR; PG8_MMA(1, 1, At, B1); PG8_BAR;
        }
        E(acc, cur, wr, wc, fr, fq);
        if (!has_next) break;
#pragma unroll
        for (int a = 0; a < 2; ++a)
#pragma unroll
            for (int b = 0; b < 2; ++b)
#pragma unroll
                for (int m = 0; m < 4; ++m)
#pragma unroll
                    for (int n = 0; n < 2; ++n) acc[a][b][m][n] = (f32x4){0.f, 0.f, 0.f, 0.f};
        cur = nxt; cA = nA; cB = nB; ++ui;
    }
    PG8_WAIT_V(0);
    if (wr == 0) PG8_BAR;
    PG8_BAR;
#undef PG8_SA
#undef PG8_SB
#undef PG8_STAGE
#undef PG8_LDA
#undef PG8_LDB
#undef PG8_MMA
#undef PG8_WAIT_V
#undef PG8_WAIT_L
#undef PG8_BAR
#undef PG8_SCHED
}
}

struct FEpi {
  int kind; float* xout; float* xctx; const float* xin; const float* modp; bf16_t* outb; int ldo; int slot; float scale; int layer; float* outf; const float* rs;
  __device__ __forceinline__ void operator()(const f32x4 (&acc)[2][2][4][2], const pg8::Unit& u, int wr, int wc, int fr, int fq) const {
    float4 gsv[2][2];
    if (kind == EPI_RESID) {
      const float* md0 = modp + ((size_t)layer * 3 + condof(u.pm * 256)) * NMOD + slot * D;
#pragma unroll
      for (int bj = 0; bj < 2; ++bj)
#pragma unroll
        for (int n = 0; n < 2; ++n) {
          float4 t = *(const float4*)(md0 + u.pn * 256 + bj * 128 + wc * 32 + n * 16 + fq * 4);
          gsv[bj][n] = make_float4(t.x * scale, t.y * scale, t.z * scale, t.w * scale);
        }
    }
#pragma unroll
    for (int ai = 0; ai < 2; ++ai)
#pragma unroll
      for (int m = 0; m < 4; ++m) {
        const int row = u.pm * 256 + ai * 128 + wr * 64 + m * 16 + fr;
        if (kind == EPI_SWIGLU) {
#pragma unroll
          for (int bj = 0; bj < 2; ++bj) {
            int hc = u.pn * 128 + bj * 64 + wc * 16 + fq * 4;
            f32x4 g = acc[ai][bj][m][0], up = acc[ai][bj][m][1];
            uint2 o; o.x = pack2(siluf_(g[0]) * up[0], siluf_(g[1]) * up[1]); o.y = pack2(siluf_(g[2]) * up[2], siluf_(g[3]) * up[3]);
            *(uint2*)(outb + (size_t)row * ldo + hc) = o;
          }
        } else if (kind == EPI_RESID) {
          float* xb;
          { int b_ = row >= TPB ? 1 : 0; int u_ = row - b_ * TPB;
            xb = (u_ < CTX) ? xctx + (size_t)(b_ * CTX + u_) * D : xout + ((size_t)b_ * SEQ + (u_ - CTX)) * D; }
          const float* xr = (xb >= xout && xb < xout + (size_t)2 * SEQ * D) ? xin + (xb - xout) : xb;
#pragma unroll
          for (int bj = 0; bj < 2; ++bj)
#pragma unroll
            for (int n = 0; n < 2; ++n) {
              int cc = u.pn * 256 + bj * 128 + wc * 32 + n * 16 + fq * 4;
              const float4 gs = gsv[bj][n];
              float4 xv = *(const float4*)(xr + cc);
              f32x4 a = acc[ai][bj][m][n];
              xv.x += gs.x * a[0]; xv.y += gs.y * a[1]; xv.z += gs.z * a[2]; xv.w += gs.w * a[3];
              *(float4*)(xb + cc) = xv;
            }
        } else if (kind == EPI_E1) {
#pragma unroll
          for (int bj = 0; bj < 2; ++bj)
#pragma unroll
            for (int n = 0; n < 2; ++n) {
              int cc = u.pn * 256 + bj * 128 + wc * 32 + n * 16 + fq * 4;
              float sc = (cc >= 1184 && cc < 1696) ? 0.08838834764831845f : 1.0f;
              f32x4 a = acc[ai][bj][m][n];
              uint2 o; o.x = pack2(a[0] * sc, a[1] * sc); o.y = pack2(a[2] * sc, a[3] * sc);
              *(uint2*)(outb + (size_t)row * PW + cc) = o;
              if (cc >= 2720 && cc < 2736) *(float4*)(outf + (size_t)row * 16 + (cc - 2720)) = make_float4(a[0], a[1], a[2], a[3]);
            }
        } else {
          float rsv = (kind == EPI_ROWSCALE) ? rs[(size_t)row * 2] : 1.0f;
#pragma unroll
          for (int bj = 0; bj < 2; ++bj)
#pragma unroll
            for (int n = 0; n < 2; ++n) {
              int cc = u.pn * 256 + bj * 128 + wc * 32 + n * 16 + fq * 4;
              f32x4 a = acc[ai][bj][m][n];
              uint2 o; o.x = pack2(a[0] * rsv, a[1] * rsv); o.y = pack2(a[2] * rsv, a[3] * rsv);
              *(uint2*)(outb + (size_t)row * ldo + cc) = o;
            }
        }
      }
  }
};

template <int KIND>
struct FEpiK : FEpi {
  __device__ __forceinline__ void operator()(const f32x4 (&acc)[2][2][4][2], const pg8::Unit& u, int wr, int wc, int fr, int fq) const {
    FEpi e = *this; e.kind = KIND; e(acc, u, wr, wc, fr, fq);
  }
};

template <int KIND>
__device__ __forceinline__ void fast_gemm(const Params& p, FEpi e, const bf16_t* A, int lda, const bf16_t* Bt, int K, int nN, int latent, char* smem) {
  pg8::Sched S; S.init(latent ? 64 : 66, nN, gridDim.x, obid(), latent);
  pg8::Gemm g{A, lda, Bt, K};
  FEpiK<KIND> ek; *(FEpi*)&ek = e; ek.xout = p.out; ek.xctx = p.ctxres(); ek.modp = p.mod(); ek.xin = e.xin ? e.xin : p.out;
  pg8::gemm_phase(( __attribute__((address_space(3))) unsigned char*)smem, g, S, ek);
}

template <int KIND>
__device__ __forceinline__ void ctx_gemm(const Params& p, const FEpi& e, const bf16_t* A, int lda, const bf16_t* Bt, int K, int col0, int ncg, char* smem) {
  const int tid = otid(), lane = tid & 63, w = tid >> 6, fr = lane & 15, fq = lane >> 4;
  bf16_t* sA = (bf16_t*)smem;
  bf16_t* sB = sA + 2 * 32 * 136;
  const int mr = w & 1, nc = w >> 1;
  for (int it = obid(); it < 16 * ncg; it += gridDim.x) {
    const int rg = it & 15, cgp = it >> 4;
    const int cr0 = rg * 32;
    const int rowb = (cr0 >> 8) * TPB + (cr0 & 255);
    const int cb = col0 + cgp * 64;
    const int r0 = tid >> 4, ch = (tid & 15) * 8;
    const bf16_t* g0 = A + (size_t)(rowb + r0) * lda + ch;
    const bf16_t* g1 = Bt + (size_t)(cb + r0) * K + ch;
    const bf16_t* g2 = Bt + (size_t)(cb + 32 + r0) * K + ch;
    const int l0 = r0 * 136 + ch;
    uint4 v0 = *(const uint4*)g0, v1 = *(const uint4*)g1, v2 = *(const uint4*)g2;
    *(uint4*)(sA + l0) = v0; *(uint4*)(sB + l0) = v1; *(uint4*)(sB + 32 * 136 + l0) = v2;
    __syncthreads();
    f32x4 acc = (f32x4){0.f, 0.f, 0.f, 0.f};
    const int nk = K >> 7;
    for (int kt = 0; kt < nk; ++kt) {
      const int buf = kt & 1;
      if (kt + 1 < nk) { v0 = *(const uint4*)(g0 + (kt + 1) * 128); v1 = *(const uint4*)(g1 + (kt + 1) * 128); v2 = *(const uint4*)(g2 + (kt + 1) * 128); }
      const bf16_t* cA = sA + buf * 32 * 136 + (mr * 16 + fr) * 136 + fq * 8;
      const bf16_t* cB = sB + buf * 64 * 136 + (nc * 16 + fr) * 136 + fq * 8;
#pragma unroll
      for (int ks = 0; ks < 4; ++ks) {
        bf16x8 a = *(const bf16x8*)(cA + ks * 32);
        bf16x8 b = *(const bf16x8*)(cB + ks * 32);
        acc = MFMA16(b, a, acc);
        asm volatile("" :: "v"(a), "v"(b));
      }
      if (kt + 1 < nk) {
        bf16_t* dA = sA + (buf ^ 1) * 32 * 136; bf16_t* dB = sB + (buf ^ 1) * 64 * 136;
        *(uint4*)(dA + l0) = v0; *(uint4*)(dB + l0) = v1; *(uint4*)(dB + 32 * 136 + l0) = v2;
      }
      __syncthreads();
    }
    const int row = rowb + mr * 16 + fr, cc = cb + nc * 16 + fq * 4;
    if (KIND == EPI_RESID) {
      float* xb = xrow(p, row);
      const float* md = p.mod() + ((size_t)e.layer * 3 + 2) * NMOD + e.slot * D;
      float4 gs = *(const float4*)(md + cc);
      float4 xv = *(float4*)(xb + cc);
      xv.x += e.scale * gs.x * acc[0]; xv.y += e.scale * gs.y * acc[1]; xv.z += e.scale * gs.z * acc[2]; xv.w += e.scale * gs.w * acc[3];
      *(float4*)(xb + cc) = xv;
    } else {
      uint2 o; o.x = pack2(acc[0], acc[1]); o.y = pack2(acc[2], acc[3]);
      *(uint2*)(e.outb + (size_t)row * e.ldo + cc) = o;
    }
  }
}

template <int EPI>
__device__ __forceinline__ void gemm_phase(const Params& p, const EpiArgs& ea, const bf16_t* A, int lda, const bf16_t* Bt, int K,
                           int Mtiles, int Ntiles, int a_mode, int rot, char* smem) {
  const int G = gridDim.x;
  const int ntiles = Mtiles * Ntiles;
  int vb = obid() - (rot % G); if (vb < 0) vb += G;
  const int nxcd = 8;
  const int per = G / nxcd;
  const int x = vb % nxcd, kk = vb / nxcd;
  for (int r = 0;; ++r) {
    int L = (r * nxcd + x) * per + kk;
    if (L >= ntiles) { if ((r * nxcd) * per >= ntiles) break; else continue; }
    int band = L / (4 * Ntiles);
    int rem = L - band * 4 * Ntiles;
    int bm = Mtiles - band * 4; if (bm > 4) bm = 4;
    int nt = rem / bm, mi = rem - nt * bm;
    int mt = band * 4 + mi;
    const bf16_t* Ap = A;
    if (a_mode == 1) Ap = A + (nt >> 1) * 128;
    gemm_tile<EPI>(p, ea, Ap, lda, Bt, K, mt * 256, nt * 128, smem);
  }
}

__device__ __forceinline__ int mchunk_tok(int dir, int j, int r) {
  if (dir == 0) return j * 64 + r;
  int c = (j < 4) ? (3 - j) : (135 - j);
  return c * 64 + 63 - r;
}

__device__ __forceinline__ void m1_phase(const Params& p, char* smem) {
  const int tid = otid(), lane = tid & 63, w = tid >> 6, fr = lane & 15, fq = lane >> 4;
  for (int row = obid() * 8 + w; row < NTOK; row += gridDim.x * 8) {
    const bf16_t* pr = p.ACT() + (size_t)row * PW;
    float sq = 0, skv = 0;
#pragma unroll
    for (int i = 0; i < 6; ++i) { float v = bf2f(pr[i * 64 + lane]); sq += v * v; }
#pragma unroll
    for (int i = 0; i < 4; ++i) { float v = bf2f(pr[384 + i * 64 + lane]); skv += v * v; }
    sq = wave_sum(sq); skv = wave_sum(skv);
    if (lane == 0) {
      p.RS()[(size_t)row * 2] = rsqrtf(sq * (1.0f / 384.0f) + 1e-6f);
      p.RS()[(size_t)row * 2 + 1] = rsqrtf(skv * (1.0f / 256.0f) + 1e-6f);
    }
    if (lane < 32) p.KR()[(size_t)row * 32 + lane] = pr[640 + lane];
  }
  bf16_t* Kt = (bf16_t*)smem;
  bf16_t* Vt = Kt + 128 * 72;
  float* wv = (float*)(Vt + 128 * 72);
  for (int it = obid(); it < NCHAIN * NCHUNK; it += gridDim.x) {
    int ci = it / NCHUNK, j = it - ci * NCHUNK;
    int dir = ci & 1, h = (ci >> 1) & 3, b = ci >> 3;
    int rowbase = b * TPB;
    if (w == 0) {
      int row = rowbase + mchunk_tok(dir, j, lane);
      float gi = p.G()[(size_t)row * 16 + (2 * dir) * 4 + h] + p.mlstm_gate_b[(2 * dir) * 4 + h];
      float gf = p.G()[(size_t)row * 16 + (2 * dir + 1) * 4 + h] + p.mlstm_gate_b[(2 * dir + 1) * 4 + h];
      float bsum = logsigmoidf_(gf);
#pragma unroll
      for (int o = 1; o < 64; o <<= 1) { float t = __shfl_up(bsum, o); if (lane >= o) bsum += t; }
      float be = __shfl(bsum, 63);
      float gg = be - bsum + gi;
      float ml = wave_max(gg);
      wv[lane] = __expf(gg - ml);
      if (lane == 0) { p.mloc()[it] = ml; p.bend()[it] = be; }
    }
    __syncthreads();
#pragma unroll
    for (int i = 0; i < 2; ++i) {
      int idx = tid + i * NTHR;
      int r = idx & 63, fc = (idx >> 6) * 8;
      int row = rowbase + mchunk_tok(dir, j, r);
      const bf16_t* src = p.ACT() + (size_t)row * PW;
      uint4 kv = *(const uint4*)(src + 1184 + h * 128 + fc);
      uint4 vv = *(const uint4*)(src + 1696 + h * 128 + fc);
      float wr = wv[r];
      const bf16_t* ke = (const bf16_t*)&kv; const bf16_t* ve = (const bf16_t*)&vv;
#pragma unroll
      for (int e = 0; e < 8; ++e) {
        Kt[(fc + e) * 72 + r] = ke[e];
        Vt[(fc + e) * 72 + r] = f2bf(bf2f(ve[e]) * wr);
      }
    }
    __syncthreads();
    f32x4 acc[8];
#pragma unroll
    for (int ni = 0; ni < 8; ++ni) acc[ni] = (f32x4){0.f, 0.f, 0.f, 0.f};
#pragma unroll
    for (int ks = 0; ks < 2; ++ks) {
      bf16x8 a = *(const bf16x8*)(Vt + (w * 16 + fr) * 72 + ks * 32 + fq * 8);
#pragma unroll
      for (int ni = 0; ni < 8; ++ni) {
        bf16x8 bb = *(const bf16x8*)(Kt + (ni * 16 + fr) * 72 + ks * 32 + fq * 8);
        acc[ni] = MFMA16(a, bb, acc[ni]);
      }
    }
    bf16_t* dC = p.R() + (size_t)it * 16384;
#pragma unroll
    for (int ni = 0; ni < 8; ++ni)
#pragma unroll
      for (int jj = 0; jj < 4; ++jj) dC[(w * 16 + fq * 4 + jj) * 128 + ni * 16 + fr] = f2bf(acc[ni][jj]);
    if (tid < 128) {
      float s = 0;
#pragma unroll 8
      for (int r = 0; r < 64; ++r) s += wv[r] * bf2f(Kt[tid * 72 + r]);
      p.dn()[(size_t)it * 128 + tid] = s;
    }
    __syncthreads();
  }
}

__device__ __forceinline__ void m2_phase(const Params& p) {
  const int tid = otid();
  for (int it = obid(); it < NCHAIN * 16; it += gridDim.x) {
    int ci = it >> 4, sl = it & 15;
    float C0 = 0, C1 = 0, m = 0, nn = 0;
    const bool don = (sl == 0 && tid < 128);
    uint32_t* base = (uint32_t*)(p.R() + (size_t)ci * NCHUNK * 16384 + sl * 1024) + tid;
    constexpr int GRP = 33;
#pragma unroll 1
    for (int j0 = 0; j0 < NCHUNK; j0 += GRP) {
      uint32_t d[GRP]; float ml[GRP], be[GRP], dnv[GRP];
#pragma unroll
      for (int q = 0; q < GRP; ++q) {
        int sidx = ci * NCHUNK + j0 + q;
        d[q] = base[(size_t)(j0 + q) * 8192];
        ml[q] = p.mloc()[sidx]; be[q] = p.bend()[sidx];
        dnv[q] = don ? p.dn()[(size_t)sidx * 128 + tid] : 0.0f;
      }
#pragma unroll
      for (int q = 0; q < GRP; ++q) {
        int sidx = ci * NCHUNK + j0 + q;
        base[(size_t)(j0 + q) * 8192] = pack2(C0, C1);
        if (don) p.nst()[(size_t)sidx * 128 + tid] = nn;
        if (sl == 0 && tid == 0) p.mst()[sidx] = m;
        float mn = fmaxf(be[q] + m, ml[q]);
        float a = __expf(be[q] + m - mn), bb = __expf(ml[q] - mn);
        C0 = a * C0 + bb * lo2f(d[q]);
        C1 = a * C1 + bb * hi2f(d[q]);
        nn = a * nn + bb * dnv[q];
        m = mn;
      }
    }
  }
}

__device__ __forceinline__ void m3_phase(const Params& p, char* smem) {
  const int tid = otid(), lane = tid & 63, w = tid >> 6, fr = lane & 15, fq = lane >> 4;
  bf16_t* Qs = (bf16_t*)smem;
  bf16_t* Ks = Qs + 64 * 136;
  bf16_t* Vt = Ks + 64 * 136;
  bf16_t* Cs = Vt + 128 * 72;
  bf16_t* Sw = Cs + 128 * 136;
  float* hs = (float*)(Sw + 64 * 72);
  float* cs = hs + 64 * 132;
  float* rt = cs + 64;
  float* wint = rt + 64;
  float* emt = wint + 64;
  float* qn = emt + 64;
  float* denp = qn + 64;
  float* ns = denp + 128;
  bf16_t* MIX = p.H();
  for (int it = obid(); it < 8 * NCHUNK; it += gridDim.x) {
    int bh = it / NCHUNK, c = it - bh * NCHUNK;
    int b = bh >> 2, h = bh & 3;
    int rowbase = b * TPB;
    for (int dir = 0; dir < 2; ++dir) {
      int ci = (b * 4 + h) * 2 + dir;
      int j = (dir == 0) ? c : ((c < 4) ? (3 - c) : (135 - c));
      int sidx = ci * NCHUNK + j;
      if (w == 0) {
        int row = rowbase + mchunk_tok(dir, j, lane);
        float gi = p.G()[(size_t)row * 16 + (2 * dir) * 4 + h] + p.mlstm_gate_b[(2 * dir) * 4 + h];
        float gf = p.G()[(size_t)row * 16 + (2 * dir + 1) * 4 + h] + p.mlstm_gate_b[(2 * dir + 1) * 4 + h];
        float bsum = logsigmoidf_(gf);
#pragma unroll
        for (int o = 1; o < 64; o <<= 1) { float t = __shfl_up(bsum, o); if (lane >= o) bsum += t; }
        float cv = gi - bsum;
        float pm = cv;
#pragma unroll
        for (int o = 1; o < 64; o <<= 1) { float t = __shfl_up(pm, o); if (lane >= o) pm = fmaxf(pm, t); }
        float mprev = p.mst()[sidx];
        float mt = fmaxf(bsum + mprev, bsum + pm);
        cs[lane] = cv;
        rt[lane] = bsum - mt;
        wint[lane] = __expf(bsum + mprev - mt);
        emt[lane] = __expf(-mt);
      }
      if (tid < 128) ns[tid] = p.nst()[(size_t)sidx * 128 + tid];
#pragma unroll
      for (int i = 0; i < 2; ++i) {
        int idx = tid + i * NTHR;
        int r = idx & 63, fc = (idx >> 6) * 8;
        int row = rowbase + mchunk_tok(dir, j, r);
        const bf16_t* src = p.ACT() + (size_t)row * PW;
        uint4 qv = *(const uint4*)(src + 672 + h * 128 + fc);
        uint4 kv = *(const uint4*)(src + 1184 + h * 128 + fc);
        uint4 vv = *(const uint4*)(src + 1696 + h * 128 + fc);
        *(uint4*)(Qs + r * 136 + fc) = qv;
        *(uint4*)(Ks + r * 136 + fc) = kv;
        const bf16_t* ve = (const bf16_t*)&vv;
#pragma unroll
        for (int e = 0; e < 8; ++e) Vt[(fc + e) * 72 + r] = ve[e];
      }
      {
        const bf16_t* cst = p.R() + (size_t)sidx * 16384;
#pragma unroll
        for (int i = 0; i < 4; ++i) {
          int idx = tid + i * NTHR;
          int v = idx >> 4, kc = (idx & 15) * 8;
          *(uint4*)(Cs + v * 136 + kc) = *(const uint4*)(cst + v * 128 + kc);
        }
      }
      __syncthreads();
      {
        const int mi = w & 3, nb2 = (w >> 2) * 2;
        f32x4 s2[2] = {(f32x4){0.f, 0.f, 0.f, 0.f}, (f32x4){0.f, 0.f, 0.f, 0.f}};
#pragma unroll
        for (int ks = 0; ks < 4; ++ks) {
          bf16x8 a = *(const bf16x8*)(Qs + (mi * 16 + fr) * 136 + ks * 32 + fq * 8);
#pragma unroll
          for (int q = 0; q < 2; ++q) {
            bf16x8 bb = *(const bf16x8*)(Ks + ((nb2 + q) * 16 + fr) * 136 + ks * 32 + fq * 8);
            s2[q] = MFMA16(a, bb, s2[q]);
          }
        }
        float rsum[4] = {0, 0, 0, 0};
#pragma unroll
        for (int q = 0; q < 2; ++q) {
          int s = (nb2 + q) * 16 + fr;
          float csv = cs[s];
#pragma unroll
          for (int jj = 0; jj < 4; ++jj) {
            int t = mi * 16 + fq * 4 + jj;
            float wgt = (s <= t) ? __expf(rt[t] + csv) : 0.0f;
            bf16_t hb = f2bf(s2[q][jj] * wgt);
            Sw[t * 72 + s] = hb;
            rsum[jj] += bf2f(hb);
          }
        }
#pragma unroll
        for (int jj = 0; jj < 4; ++jj) {
          float v = rsum[jj];
          v += __shfl_xor(v, 1); v += __shfl_xor(v, 2); v += __shfl_xor(v, 4); v += __shfl_xor(v, 8);
          if (fr == 0) denp[(w >> 2) * 64 + mi * 16 + fq * 4 + jj] = v;
        }
        {
          int t = tid >> 3, k0 = (tid & 7) * 16;
          float s = 0;
#pragma unroll
          for (int k = 0; k < 16; ++k) s += bf2f(Qs[t * 136 + k0 + k]) * ns[k0 + k];
          s += __shfl_xor(s, 1); s += __shfl_xor(s, 2); s += __shfl_xor(s, 4);
          if ((tid & 7) == 0) qn[t] = s;
        }
      }
      __syncthreads();
      {
        const int mi = w & 3, nh = w >> 2;
        f32x4 a1[4], a2[4];
#pragma unroll
        for (int q = 0; q < 4; ++q) { a1[q] = (f32x4){0.f, 0.f, 0.f, 0.f}; a2[q] = (f32x4){0.f, 0.f, 0.f, 0.f}; }
#pragma unroll
        for (int ks = 0; ks < 2; ++ks) {
          bf16x8 a = *(const bf16x8*)(Sw + (mi * 16 + fr) * 72 + ks * 32 + fq * 8);
#pragma unroll
          for (int q = 0; q < 4; ++q) {
            bf16x8 bb = *(const bf16x8*)(Vt + ((nh * 4 + q) * 16 + fr) * 72 + ks * 32 + fq * 8);
            a1[q] = MFMA16(a, bb, a1[q]);
          }
        }
#pragma unroll
        for (int ks = 0; ks < 4; ++ks) {
          bf16x8 a = *(const bf16x8*)(Qs + (mi * 16 + fr) * 136 + ks * 32 + fq * 8);
#pragma unroll
          for (int q = 0; q < 4; ++q) {
            bf16x8 bb = *(const bf16x8*)(Cs + ((nh * 4 + q) * 16 + fr) * 136 + ks * 32 + fq * 8);
            a2[q] = MFMA16(a, bb, a2[q]);
          }
        }
#pragma unroll
        for (int jj = 0; jj < 4; ++jj) {
          int t = mi * 16 + fq * 4 + jj;
          float wi = wint[t];
          float den = denp[t] + denp[64 + t] + wi * qn[t];
          float inv = 1.0f / fmaxf(fabsf(den), emt[t]);
          int tl = (dir == 0) ? t : (63 - t);
#pragma unroll
          for (int q = 0; q < 4; ++q) {
            int v = (nh * 4 + q) * 16 + fr;
            float hv = (a1[q][jj] + wi * a2[q][jj]) * inv;
            if (dir == 0) hs[tl * 132 + v] = hv; else hs[tl * 132 + v] += hv;
          }
        }
      }
      __syncthreads();
    }
    for (int q = 0; q < 8; ++q) {
      int tl = w * 8 + q;
      float v0 = hs[tl * 132 + lane], v1 = hs[tl * 132 + 64 + lane];
      float ss = wave_sum(v0 * v0 + v1 * v1);
      float rstd = rsqrtf(ss * (1.0f / 128.0f) + 1e-6f);
      int row = rowbase + c * 64 + tl;
      const bf16_t* po = p.ACT() + (size_t)row * PW + 2208 + h * 128;
      float o0 = bf2f(po[lane]), o1 = bf2f(po[64 + lane]);
      float y0 = v0 * rstd * p.mlstm_out_g[h * 128 + lane] * sigmoidf_(o0);
      float y1 = v1 * rstd * p.mlstm_out_g[h * 128 + 64 + lane] * sigmoidf_(o1);
      MIX[(size_t)row * D + 512 + h * 128 + lane] = f2bf(y0);
      MIX[(size_t)row * D + 512 + h * 128 + 64 + lane] = f2bf(y1);
    }
    __syncthreads();
  }
}

__device__ __forceinline__ void norm_rope_32(float* x, const float* g, bool latent, int t, const float2* tab) {
  float ss = 0;
#pragma unroll
  for (int i = 0; i < 32; ++i) ss += x[i] * x[i];
  float rstd = rsqrtf(ss * (1.0f / 32.0f) + 1e-6f);
#pragma unroll
  for (int i = 0; i < 32; ++i) x[i] = x[i] * rstd * g[i];
  if (latent) {
#pragma unroll
    for (int a = 0; a < 2; ++a) {
      const int pos = (a == 0 ? (t >> 6) : (t & 63));
#pragma unroll
      for (int i = 0; i < 8; ++i) {
        float2 cs = tab[pos * 8 + i];
        float x1 = x[a * 16 + i], x2 = x[a * 16 + 8 + i];
        x[a * 16 + i] = x1 * cs.x - x2 * cs.y;
        x[a * 16 + 8 + i] = x2 * cs.x + x1 * cs.y;
      }
    }
  }
}

__device__ __forceinline__ void load32(const bf16_t* src, float* x) {
  const uint4* s4 = (const uint4*)src;
#pragma unroll
  for (int i = 0; i < 4; ++i) {
    uint4 v = s4[i];
    x[i * 8 + 0] = lo2f(v.x); x[i * 8 + 1] = hi2f(v.x); x[i * 8 + 2] = lo2f(v.y); x[i * 8 + 3] = hi2f(v.y);
    x[i * 8 + 4] = lo2f(v.z); x[i * 8 + 5] = hi2f(v.z); x[i * 8 + 6] = lo2f(v.w); x[i * 8 + 7] = hi2f(v.w);
  }
}
__device__ __forceinline__ void post_phase(const Params& p) {
  const bf16_t* QRAW = p.R();
  const bf16_t* KVRAW = p.R() + (size_t)NTOK * 768;
  bf16_t* Qo = p.ACT();
  bf16_t* Ko = p.ACT() + (size_t)16 * TPB * 96;
  const float qscale = 0.10206207261596577f * 1.4426950408889634f;
  const int tid = otid();
  for (int gi = obid() * NTHR + tid; gi < 4 * NTOK * 8; gi += gridDim.x * NTHR) {
    const int part = gi / (NTOK * 8);
    const int idx = gi - part * (NTOK * 8);
    int row = idx >> 3, h = idx & 7;
    int b = row >= TPB ? 1 : 0, u = row - b * TPB;
    bool latent = u >= CTX; int t = u - CTX;
    size_t obase = ((size_t)(b * 8 + h) * TPB + u) * 96;
    float knorm2 = 0.f;
    if (part < 2) {
      const bf16_t* src = part == 0 ? QRAW + (size_t)row * 768 + h * 96 : KVRAW + (size_t)row * 1024 + h * 128;
      const float* gn = part == 0 ? p.mla_q_g : p.mla_k_g;
      float x[64]; float ss = 0;
      load32(src, x); load32(src + 32, x + 32);
#pragma unroll
      for (int i = 0; i < 64; ++i) ss += x[i] * x[i];
      float rstd = rsqrtf(ss * (1.0f / 64.0f) + 1e-6f) * (part == 0 ? qscale : 1.0f);
      uint4* dst = (uint4*)((part == 0 ? Qo : Ko) + obase);
#pragma unroll
      for (int i = 0; i < 8; ++i) {
        float y[8];
#pragma unroll
        for (int e = 0; e < 8; ++e) { y[e] = x[i * 8 + e] * rstd * gn[i * 8 + e]; knorm2 += y[e] * y[e]; }
        uint4 o;
        o.x = pack2(y[0], y[1]); o.y = pack2(y[2], y[3]); o.z = pack2(y[4], y[5]); o.w = pack2(y[6], y[7]);
        dst[i] = o;
      }
    } else {
      const bf16_t* src = part == 2 ? QRAW + (size_t)row * 768 + h * 96 + 64 : p.KR() + (size_t)row * 32;
      float x[32];
      load32(src, x);
      norm_rope_32(x, (part == 2 ? p.mla_q_g : p.mla_k_g) + 64, latent, t, p.ropetab());
      const float sc = part == 2 ? qscale : 1.0f;
      uint4* dst = (uint4*)((part == 2 ? Qo : Ko) + obase + 64);
#pragma unroll
      for (int i = 0; i < 4; ++i) {
        float y[8];
#pragma unroll
        for (int e = 0; e < 8; ++e) { y[e] = x[i * 8 + e] * sc; knorm2 += y[e] * y[e]; }
        uint4 o;
        o.x = pack2(y[0], y[1]); o.y = pack2(y[2], y[3]); o.z = pack2(y[4], y[5]); o.w = pack2(y[6], y[7]);
        dst[i] = o;
      }
    }
    if (part == 1 || part == 3) {
      knorm2 = fmaxf(knorm2, __shfl_xor(knorm2, 8));
      knorm2 = fmaxf(knorm2, __shfl_xor(knorm2, 16));
      knorm2 = fmaxf(knorm2, __shfl_xor(knorm2, 32));
      if ((tid & 63) < 8) atomicMax(p.kmax2() + (part == 1 ? 0 : 16) + (b * 8 + h), __float_as_uint(knorm2));
    }
  }
}

__device__ __forceinline__ void vt_scatter(bf16_t* dst, int stride, uint4 v) {
  dst[0 * stride] = (bf16_t)(v.x & 0xFFFF); dst[1 * stride] = (bf16_t)(v.x >> 16);
  dst[2 * stride] = (bf16_t)(v.y & 0xFFFF); dst[3 * stride] = (bf16_t)(v.y >> 16);
  dst[4 * stride] = (bf16_t)(v.z & 0xFFFF); dst[5 * stride] = (bf16_t)(v.z >> 16);
  dst[6 * stride] = (bf16_t)(v.w & 0xFFFF); dst[7 * stride] = (bf16_t)(v.w >> 16);
}
constexpr int KLD = 104, VLD = 136, KT = 128;
__device__ __forceinline__ void attn_phase(const Params& p, char* smem) {
  const int tid = otid(), lane = tid & 63, w = tid >> 6, fr = lane & 15, fq = lane >> 4;
  bf16_t* Ks = (bf16_t*)smem;
  bf16_t* Vt = Ks + 2 * KT * KLD;
  const bf16_t* Qg = p.ACT();
  const bf16_t* Kg = p.ACT() + (size_t)16 * TPB * 96;
  const bf16_t* KVRAW = p.R() + (size_t)NTOK * 768;
  bf16_t* MIX = p.H();
  for (int it = obid(); it < 272; it += gridDim.x) {
    int bh, qu0, nq, nkeys;
    if (it < 256) { int xx = it & 7, k = it >> 3; bh = 2 * xx + (k >> 4); qu0 = CTX + (k & 15) * 512; nq = 512; nkeys = TPB; }
    else { bh = it - 256; qu0 = 0; nq = 256; nkeys = CTX; }
    const int b = bh >> 3, h = bh & 7;
    const bool active = (w * 64) < nq;
    bf16x8 qf[4][3];
    if (active) {
#pragma unroll
      for (int g = 0; g < 4; ++g) {
        const bf16_t* qp = Qg + ((size_t)bh * TPB + qu0 + w * 64 + g * 16 + fr) * 96 + fq * 8;
#pragma unroll
        for (int ds = 0; ds < 3; ++ds) qf[g][ds] = *(const bf16x8*)(qp + ds * 32);
      }
    }
    f32x4 oT[4][4];
    float mneg[4], lrun[4];
    float bmax = 0.f;
    {
      const float kmx = sqrtf(__uint_as_float(p.kmax2()[bh]) + __uint_as_float(p.kmax2()[16 + bh])) * 1.01f;
#pragma unroll
      for (int g = 0; g < 4; ++g) {
        float qs = 0.f;
        if (active) {
#pragma unroll
          for (int ds = 0; ds < 3; ++ds)
#pragma unroll
            for (int e = 0; e < 8; ++e) { float qv = bf2f((bf16_t)qf[g][ds][e]); qs += qv * qv; }
        }
        qs += __shfl_xor(qs, 16); qs += __shfl_xor(qs, 32);
        mneg[g] = -sqrtf(qs) * kmx;
        bmax = fmaxf(bmax, -mneg[g]);
        lrun[g] = 0.f;
#pragma unroll
        for (int q = 0; q < 4; ++q) oT[g][q] = (f32x4){0.f, 0.f, 0.f, 0.f};
      }
    }
    const bool stab = __any(bmax > 60.0f) != 0;
    const bf16_t* kbase = Kg + (size_t)bh * TPB * 96;
    const bf16_t* vbase = KVRAW + (size_t)b * TPB * 1024 + h * 128 + 64;
#define kgo ((tid >> 2) * 96 + (tid & 3) * 24)
#define klo ((tid >> 2) * KLD + (tid & 3) * 24)
#define vkey0 (tid >> 3)
#define vch (tid & 7)
    uint4 rk0, rk1, rk2, rv0, rv1;
    const int nkt = nkeys / KT;
    rk0 = *(const uint4*)(kbase + kgo); rk1 = *(const uint4*)(kbase + kgo + 8); rk2 = *(const uint4*)(kbase + kgo + 16);
    rv0 = *(const uint4*)(vbase + (size_t)vkey0 * 1024 + vch * 8); rv1 = *(const uint4*)(vbase + (size_t)(vkey0 + 64) * 1024 + vch * 8);
    {
      *(uint4*)(Ks + klo) = rk0; *(uint4*)(Ks + klo + 8) = rk1; *(uint4*)(Ks + klo + 16) = rk2;
      vt_scatter(Vt + (vch * 8) * VLD + vkey0, VLD, rv0); vt_scatter(Vt + (vch * 8) * VLD + vkey0 + 64, VLD, rv1);
    }
    __syncthreads();
    for (int kt = 0; kt < nkt; ++kt) {
      const int buf = kt & 1;
      if (kt + 1 < nkt) {
        size_t ko = (size_t)(kt + 1) * KT;
        rk0 = *(const uint4*)(kbase + ko * 96 + kgo); rk1 = *(const uint4*)(kbase + ko * 96 + kgo + 8); rk2 = *(const uint4*)(kbase + ko * 96 + kgo + 16);
        rv0 = *(const uint4*)(vbase + (ko + vkey0) * 1024 + vch * 8); rv1 = *(const uint4*)(vbase + (ko + vkey0 + 64) * 1024 + vch * 8);
      }
      if (active) {
        const bf16_t* cK = Ks + buf * KT * KLD;
        const bf16_t* cV = Vt + buf * 64 * VLD;
#pragma unroll 1
        for (int ks = 0; ks < 4; ++ks) {
          uint32_t pfu[4][4];
#pragma unroll
          for (int kf = 0; kf < 2; ++kf) {
            f32x4 sT[4];
#pragma unroll
            for (int g = 0; g < 4; ++g) sT[g] = (f32x4){0.f, 0.f, 0.f, 0.f};
#pragma unroll
            for (int ds = 0; ds < 3; ++ds) {
              bf16x8 ka = *(const bf16x8*)(cK + (ks * 32 + kf * 16 + fr) * KLD + ds * 32 + fq * 8);
#pragma unroll
              for (int g = 0; g < 4; ++g) sT[g] = MFMA16(ka, qf[g][ds], sT[g]);
            }
            if (stab) {
#pragma unroll
              for (int g = 0; g < 4; ++g) { sT[g][0] += mneg[g]; sT[g][1] += mneg[g]; sT[g][2] += mneg[g]; sT[g][3] += mneg[g]; }
            }
#pragma unroll
            for (int g = 0; g < 4; ++g) {
              float p0 = __builtin_amdgcn_exp2f(sT[g][0]), p1 = __builtin_amdgcn_exp2f(sT[g][1]);
              float p2 = __builtin_amdgcn_exp2f(sT[g][2]), p3 = __builtin_amdgcn_exp2f(sT[g][3]);
              { float l_ = lrun[g]; l_ += p0; l_ += p1; l_ += p2; l_ += p3; lrun[g] = l_; }
              pfu[g][kf * 2] = pack2(p0, p1); pfu[g][kf * 2 + 1] = pack2(p2, p3);
            }
          }
          bf16x8 pf[4];
#pragma unroll
          for (int g = 0; g < 4; ++g) {
            union { uint32_t u[4]; bf16x8 v; } cvt;
            cvt.u[0] = pfu[g][0]; cvt.u[1] = pfu[g][1]; cvt.u[2] = pfu[g][2]; cvt.u[3] = pfu[g][3];
            pf[g] = cvt.v;
          }
#pragma unroll
          for (int dvf = 0; dvf < 4; ++dvf) {
            const bf16_t* vp = cV + (dvf * 16 + fr) * VLD + ks * 32 + fq * 4;
            union { uint2 u[2]; bf16x8 v; } va;
            va.u[0] = *(const uint2*)(vp);
            va.u[1] = *(const uint2*)(vp + 16);
#pragma unroll
            for (int g = 0; g < 4; ++g) oT[g][dvf] = MFMA16(va.v, pf[g], oT[g][dvf]);
          }
        }
      }
      if (kt + 1 < nkt) {
        bf16_t* dK = Ks + (buf ^ 1) * KT * KLD;
        bf16_t* dV = Vt + (buf ^ 1) * 64 * VLD;
        *(uint4*)(dK + klo) = rk0; *(uint4*)(dK + klo + 8) = rk1; *(uint4*)(dK + klo + 16) = rk2;
        vt_scatter(dV + (vch * 8) * VLD + vkey0, VLD, rv0); vt_scatter(dV + (vch * 8) * VLD + vkey0 + 64, VLD, rv1);
      }
      __syncthreads();
    }
    if (active) {
#pragma unroll
      for (int g = 0; g < 4; ++g) {
        float l = lrun[g];
        l += __shfl_xor(l, 16); l += __shfl_xor(l, 32);
        float inv = 1.0f / l;
        int row = b * TPB + qu0 + w * 64 + g * 16 + fr;
#pragma unroll
        for (int dvf = 0; dvf < 4; ++dvf) {
          uint2 o;
          o.x = pack2(oT[g][dvf][0] * inv, oT[g][dvf][1] * inv);
          o.y = pack2(oT[g][dvf][2] * inv, oT[g][dvf][3] * inv);
          *(uint2*)(MIX + (size_t)row * D + h * 64 + dvf * 16 + fq * 4) = o;
        }
      }
    }
  }
}

#undef kgo
#undef klo
#undef vkey0
#undef vch
__device__ __forceinline__ void conv_phase(const Params& p) {
  const bf16_t* O1 = p.ACT();
  const int idx0 = obid() * NTHR + otid();
  const int cc = (idx0 & 127) * 8;
  float wt[4][8], bs[8];
#pragma unroll
  for (int k = 0; k < 4; ++k) {
    float4 a = *(const float4*)(p.odd_conv_w + k * 1024 + cc), c = *(const float4*)(p.odd_conv_w + k * 1024 + cc + 4);
    wt[k][0] = a.x; wt[k][1] = a.y; wt[k][2] = a.z; wt[k][3] = a.w; wt[k][4] = c.x; wt[k][5] = c.y; wt[k][6] = c.z; wt[k][7] = c.w;
  }
  {
    float4 a = *(const float4*)(p.odd_conv_b + cc), c = *(const float4*)(p.odd_conv_b + cc + 4);
    bs[0] = a.x; bs[1] = a.y; bs[2] = a.z; bs[3] = a.w; bs[4] = c.x; bs[5] = c.y; bs[6] = c.z; bs[7] = c.w;
  }
  for (int idx = idx0; idx < NTOK * 128; idx += gridDim.x * NTHR) {
    int row = idx >> 7;
    int b = row >= TPB ? 1 : 0, u = row - b * TPB;
    int lo = (u < CTX) ? 0 : CTX, hi = (u < CTX) ? CTX : TPB;
    float acc[8];
#pragma unroll
    for (int e = 0; e < 8; ++e) acc[e] = bs[e];
#pragma unroll
    for (int k = 0; k < 4; ++k) {
      int uu = u + k - 2;
      if (uu >= lo && uu < hi) {
        uint4 v = *(const uint4*)(O1 + (size_t)(row + k - 2) * 2048 + 1024 + cc);
        acc[0] += wt[k][0] * lo2f(v.x); acc[1] += wt[k][1] * hi2f(v.x);
        acc[2] += wt[k][2] * lo2f(v.y); acc[3] += wt[k][3] * hi2f(v.y);
        acc[4] += wt[k][4] * lo2f(v.z); acc[5] += wt[k][5] * hi2f(v.z);
        acc[6] += wt[k][6] * lo2f(v.w); acc[7] += wt[k][7] * hi2f(v.w);
      }
    }
    uint4 o;
    o.x = pack2(acc[0], acc[1]); o.y = pack2(acc[2], acc[3]); o.z = pack2(acc[4], acc[5]); o.w = pack2(acc[6], acc[7]);
    *(uint4*)(p.XC() + (size_t)row * D + cc) = o;
  }
}

__device__ __forceinline__ int scan_tok(int dir, int pi) {
  if (dir == 0) return pi;
  return (pi < CTX) ? (CTX - 1 - pi) : (TPB + CTX - 1 - pi);
}

__device__ __forceinline__ void scan_step4(uint4 v, float (&h)[4]) {
  h[0] = __expf(lo2f(v.x)) * h[0] + hi2f(v.x);
  h[1] = __expf(lo2f(v.y)) * h[1] + hi2f(v.y);
  h[2] = __expf(lo2f(v.z)) * h[2] + hi2f(v.z);
  h[3] = __expf(lo2f(v.w)) * h[3] + hi2f(v.w);
}
__device__ __forceinline__ void scan1_phase(const Params& p, int dir) {
  const int tid = otid(), lane = tid & 63, w = tid >> 6;
  const uint32_t* RG = (const uint32_t*)p.R();
  float* const suma = p.SUMA(); float* const sumh = p.SUMH();
  for (int it = obid(); it < 256; it += gridDim.x) {
    const int b = it >> 7, cgp = (it >> 5) & 3, seg = it & 31;
    const int ch0 = cgp * 256 + lane * 4;
    const size_t rb = (size_t)b * TPB;
    const int pos0 = seg * 264 + w * 33;
    float h[4] = {0.f, 0.f, 0.f, 0.f}, as[4] = {0.f, 0.f, 0.f, 0.f};
    {
      uint4 v[33];
#pragma unroll
      for (int i = 0; i < 33; ++i) v[i] = *(const uint4*)(RG + (rb + scan_tok(dir, pos0 + i)) * D + ch0);
#pragma unroll
      for (int i = 0; i < 33; ++i) {
        scan_step4(v[i], h);
        as[0] += lo2f(v[i].x); as[1] += lo2f(v[i].y); as[2] += lo2f(v[i].z); as[3] += lo2f(v[i].w);
      }
    }
    const size_t e = ((size_t)(b * 4 + cgp) * 264 + seg * 8 + w) * 256 + lane * 4;
    *(float4*)(suma + e) = make_float4(as[0], as[1], as[2], as[3]);
    *(float4*)(sumh + e) = make_float4(h[0], h[1], h[2], h[3]);
  }
}
__device__ __forceinline__ void scan2_phase(const Params& p, int dir, char* smem) {
  const int tid = otid(), lane = tid & 63, w = tid >> 6;
  const uint32_t* RG = (const uint32_t*)p.R();
  float* const suma = p.SUMA(); float* const sumh = p.SUMH();
  const bf16_t* O1 = p.ACT();
  bf16_t* Y = p.H();
  float4* pA = (float4*)smem;
  float4* pH = pA + 512;
  for (int it = obid(); it < 256; it += gridDim.x) {
    const int b = it >> 7, cgp = (it >> 5) & 3, seg = it & 31;
    const int ch0 = cgp * 256 + lane * 4;
    const size_t rb = (size_t)b * TPB;
    const int pos0 = seg * 264 + w * 33;
    const size_t sb = ((size_t)(b * 4 + cgp) * 264) * 256 + lane * 4;
    {
      float a4[4] = {0.f, 0.f, 0.f, 0.f}, h4[4] = {0.f, 0.f, 0.f, 0.f};
#pragma unroll 1
      for (int q0 = 0; q0 < seg; q0 += 16) {
        float4 A[16], Hh[16];
#pragma unroll
        for (int i = 0; i < 16; ++i) {
          A[i] = make_float4(0.f, 0.f, 0.f, 0.f); Hh[i] = A[i];
          if (q0 + i < seg) { size_t e = sb + (size_t)(w * seg + q0 + i) * 256; A[i] = *(const float4*)(suma + e); Hh[i] = *(const float4*)(sumh + e); }
        }
#pragma unroll
        for (int i = 0; i < 16; ++i) {
          h4[0] = __expf(A[i].x) * h4[0] + Hh[i].x; h4[1] = __expf(A[i].y) * h4[1] + Hh[i].y; h4[2] = __expf(A[i].z) * h4[2] + Hh[i].z; h4[3] = __expf(A[i].w) * h4[3] + Hh[i].w;
          a4[0] += A[i].x; a4[1] += A[i].y; a4[2] += A[i].z; a4[3] += A[i].w;
        }
      }
      pA[w * 64 + lane] = make_float4(a4[0], a4[1], a4[2], a4[3]);
      pH[w * 64 + lane] = make_float4(h4[0], h4[1], h4[2], h4[3]);
    }
    __syncthreads();
    float h[4] = {0.f, 0.f, 0.f, 0.f};
#pragma unroll
    for (int q = 0; q < 8; ++q) {
      float4 A = pA[q * 64 + lane], Hh = pH[q * 64 + lane];
      h[0] = __expf(A.x) * h[0] + Hh.x; h[1] = __expf(A.y) * h[1] + Hh.y; h[2] = __expf(A.z) * h[2] + Hh.z; h[3] = __expf(A.w) * h[3] + Hh.w;
    }
    {
      float4 A[7], Hh[7];
#pragma unroll
      for (int q = 0; q < 7; ++q) {
        A[q] = make_float4(0.f, 0.f, 0.f, 0.f); Hh[q] = A[q];
        if (q < w) { size_t e = sb + (size_t)(seg * 8 + q) * 256; A[q] = *(const float4*)(suma + e); Hh[q] = *(const float4*)(sumh + e); }
      }
#pragma unroll
      for (int q = 0; q < 7; ++q) {
        h[0] = __expf(A[q].x) * h[0] + Hh[q].x; h[1] = __expf(A[q].y) * h[1] + Hh[q].y; h[2] = __expf(A[q].z) * h[2] + Hh[q].z; h[3] = __expf(A[q].w) * h[3] + Hh[q].w;
      }
    }
#pragma unroll 1
    for (int bt = 0; bt < 3; ++bt) {
      uint4 v[11]; uint2 hf[11], gt[11];
#pragma unroll
      for (int i = 0; i < 11; ++i) {
        size_t row = rb + scan_tok(dir, pos0 + bt * 11 + i);
        v[i] = *(const uint4*)(RG + row * D + ch0);
        if (dir == 1) { hf[i] = *(const uint2*)(Y + row * D + ch0); gt[i] = *(const uint2*)(O1 + row * 2048 + ch0); }
      }
#pragma unroll
      for (int i = 0; i < 11; ++i) {
        size_t row = rb + scan_tok(dir, pos0 + bt * 11 + i);
        scan_step4(v[i], h);
        uint2 o;
        if (dir == 0) { o.x = pack2(h[0], h[1]); o.y = pack2(h[2], h[3]); }
        else {
          float y0 = (lo2f(hf[i].x) + h[0]) * gelu_tanh(lo2f(gt[i].x));
          float y1 = (hi2f(hf[i].x) + h[1]) * gelu_tanh(hi2f(gt[i].x));
          float y2 = (lo2f(hf[i].y) + h[2]) * gelu_tanh(lo2f(gt[i].y));
          float y3 = (hi2f(hf[i].y) + h[3]) * gelu_tanh(hi2f(gt[i].y));
          o.x = pack2(y0, y1); o.y = pack2(y2, y3);
        }
        *(uint2*)(Y + row * D + ch0) = o;
      }
    }
    __syncthreads();
  }
}

#define XB_TMO      128
#define XB_XCNT(j)  (256  + 64 * (j))
#define XB_XSUB(j)  (1280 + 64 * (j))
#define XB_XGEN(j)  (2304 + 64 * (j))
#define XB_TOP      3328
#define XB_TOPGEN   3392
#define XCD_BAR_WORDS 3456
#define XB_SPIN_CAP (1u << 18)
#define LAS3 __attribute__((address_space(3)))
__device__ __forceinline__ unsigned xb_ld(unsigned* p)              { return __hip_atomic_load(p, __ATOMIC_RELAXED, __HIP_MEMORY_SCOPE_AGENT); }
__device__ __forceinline__ unsigned xb_add(unsigned* p, unsigned v) { return __hip_atomic_fetch_add(p, v, __ATOMIC_RELAXED, __HIP_MEMORY_SCOPE_AGENT); }
__device__ __forceinline__ unsigned xb_xcc_id() { return (unsigned)__builtin_amdgcn_s_getreg((3 << 11) | 20) & 0xFu; }
#define XB_SPIN(cond, bar) do { unsigned _sp = 0; while (cond) { __builtin_amdgcn_s_sleep(1); \
    if ((++_sp & 255u) == 0u) { if (xb_ld(&(bar)[XB_TMO])) break; if (_sp > XB_SPIN_CAP) { atomicAdd(&(bar)[XB_TMO], 1u); break; } } } } while (0)
struct XcdBarrier { unsigned* bar; unsigned x; volatile LAS3 unsigned* st; };
__device__ __forceinline__ XcdBarrier xcd_barrier_post(unsigned* bar, volatile LAS3 unsigned* st) {
    XcdBarrier b; b.bar = bar; b.x = xb_xcc_id(); b.st = st;
    if (threadIdx.x == 0) (void)xb_add(&bar[XB_XCNT(b.x)], 1u);
    return b;
}
__device__ __forceinline__ void xcd_barrier_complete(unsigned* bar, unsigned x, unsigned& nloc, unsigned& nx) {
    const unsigned G = gridDim.x * gridDim.y * gridDim.z;
    unsigned sum, cnt, mine, sp = 0u;
    for (;;) {
        sum = 0u; cnt = 0u; mine = 0u;
#pragma unroll
        for (unsigned j = 0; j < 16; ++j) { const unsigned c = xb_ld(&bar[XB_XCNT(j)]); sum += c; cnt += (c > 0u) ? 1u : 0u; mine = (j == x) ? c : mine; }
        if (sum == G) break;
        __builtin_amdgcn_s_sleep(1);
        if ((++sp & 255u) == 0u) { if (xb_ld(&bar[XB_TMO])) break; if (sp > XB_SPIN_CAP) { atomicAdd(&bar[XB_TMO], 1u); break; } }
    }
    nloc = mine > 0u ? mine : 1u; nx = cnt > 0u ? cnt : 1u;
}
__device__ __forceinline__ void xcd_barrier(const XcdBarrier& b) {
    asm volatile("s_waitcnt vmcnt(0)" ::: "memory");
    __syncthreads();
    if (threadIdx.x == 0) {
        unsigned* bar = b.bar;
        __builtin_amdgcn_s_waitcnt(0);
        unsigned nloc = b.st[0], nx = b.st[1];
        if (nloc == 0u) { xcd_barrier_complete(bar, b.x, nloc, nx); b.st[0] = nloc; b.st[1] = nx; }
        const unsigned old = xb_add(&bar[XB_XSUB(b.x)], 1u);
        const unsigned gen = old / nloc;
        if (old + 1u == (gen + 1u) * nloc) {
            __builtin_amdgcn_fence(__ATOMIC_RELEASE, "agent");
            asm volatile("s_waitcnt vmcnt(0)" ::: "memory");
            const unsigned og = xb_add(&bar[XB_TOP], 1u);
            const unsigned tg = og / nx;
            if (og + 1u == (tg + 1u) * nx) xb_add(&bar[XB_TOPGEN], 1u);
            else XB_SPIN(xb_ld(&bar[XB_TOPGEN]) == tg, bar);
            __builtin_amdgcn_fence(__ATOMIC_ACQUIRE, "agent");
            xb_add(&bar[XB_XGEN(b.x)], 1u);
            asm volatile("s_waitcnt vmcnt(0)" ::: "memory");
        } else {
            XB_SPIN(xb_ld(&bar[XB_XGEN(b.x)]) == gen, bar);
            __builtin_amdgcn_fence(__ATOMIC_ACQUIRE, "agent");
            asm volatile("s_waitcnt vmcnt(0)" ::: "memory");
        }
    }
    __syncthreads();
}

constexpr int NPHASE = 32;
#ifndef PHMASK
#define PHMASK 0xFFFFFFFFu
#endif
#define PHEN(n) ((PHMASK >> (n)) & 1u)

enum { K_P0 = 0, K_NORMMOD, K_FFN_UP, K_FFN_DOWN, K_E1, K_M1, K_M2, K_M3, K_UQKV, K_POST, K_ATTN, K_WOUT, K_O1, K_CONV, K_LRU, K_SCAN1, K_SCAN2 };
struct PhDesc { unsigned char kind, a0, a1, pad; };
__device__ const PhDesc PHTAB[NPHASE] = {
  {K_P0, 0, 0, 0}, {K_NORMMOD, 0, 0, 1}, {K_FFN_UP, 0, 0, 0}, {K_FFN_DOWN, 0, 1, 1}, {K_NORMMOD, 0, 1, 0}, {K_E1, 0, 0, 0}, {K_M1, 0, 0, 0}, {K_M2, 0, 0, 0},
  {K_M3, 0, 0, 0}, {K_UQKV, 0, 0, 0}, {K_POST, 0, 0, 0}, {K_ATTN, 0, 0, 0}, {K_WOUT, 0, 1, 0}, {K_NORMMOD, 0, 2, 0}, {K_FFN_UP, 1, 0, 0}, {K_FFN_DOWN, 1, 1, 0},
  {K_NORMMOD, 1, 0, 0}, {K_FFN_UP, 2, 0, 0}, {K_FFN_DOWN, 2, 1, 0}, {K_NORMMOD, 1, 1, 0}, {K_O1, 0, 0, 0}, {K_CONV, 0, 0, 0}, {K_LRU, 0, 0, 0}, {K_SCAN1, 0, 0, 0},
  {K_SCAN2, 0, 0, 0}, {K_LRU, 1, 0, 0}, {K_SCAN1, 1, 0, 0}, {K_SCAN2, 1, 0, 0}, {K_WOUT, 1, 0, 0}, {K_NORMMOD, 1, 2, 0}, {K_FFN_UP, 3, 1, 0}, {K_FFN_DOWN, 3, 0, 0}};
#ifndef KMASK
#define KMASK 0xFFFFFFFFu
#endif
#define KEN(k) ((KMASK >> (k)) & 1u)

__device__ __forceinline__ void run_phase(const Params& p, int ph, char* smem) {
  EpiArgs ea{};
  FEpi fe{};
  const int kind = PHTAB[ph].kind, a0 = PHTAB[ph].a0, a1 = PHTAB[ph].a1, a2 = PHTAB[ph].pad;
  switch (kind) {
    case K_P0: if (!KEN(K_P0)) break; p0_phase(p, smem); break;
    case K_NORMMOD: if (!KEN(K_NORMMOD)) break; normmod_phase(p, a0, a1, a2); break;
    case K_FFN_UP: if (!KEN(K_FFN_UP)) break;
      fe.outb = p.ACT(); fe.ldo = DFF;
      fast_gemm<EPI_SWIGLU>(p, fe, p.H(), D, p.Wgu(a0), D, 22, a1, smem); break;
    case K_FFN_DOWN: if (!KEN(K_FFN_DOWN)) break;
      fe.layer = a0 >> 1; fe.slot = (a0 & 1) ? 8 : 2; fe.scale = 0.5f; fe.xin = a2 ? p.x : nullptr;
      fast_gemm<EPI_RESID>(p, fe, p.ACT(), DFF, p.Wd(a0), DFF, 4, 1, smem);
      if (a1) ctx_gemm<EPI_RESID>(p, fe, p.ACT(), DFF, p.Wd(a0), DFF, 0, 16, smem);
      break;
    case K_E1: if (!KEN(K_E1)) break; fe.outb = p.ACT(); fe.outf = p.G();
      fast_gemm<EPI_E1>(p, fe, p.H(), D, p.Wein(), D, 11, 0, smem); break;
    case K_M1: if (!KEN(K_M1)) break; m1_phase(p, smem); break;
    case K_M2: if (!KEN(K_M2)) break; m2_phase(p); break;
    case K_M3: if (!KEN(K_M3)) break; m3_phase(p, smem); break;
    case K_UQKV: if (!KEN(K_UQKV)) break;
      for (int q = 0; q < 2; ++q) {
        fe.outb = q ? p.R() + (size_t)NTOK * 768 : p.R(); fe.ldo = q ? 1024 : 768; fe.rs = p.RS() + q;
        fast_gemm<EPI_ROWSCALE>(p, fe, p.ACT() + (q ? 384 : 0), PW, q ? p.Wukv() : p.Wuq(), q ? 256 : 384, q ? 4 : 3, 0, smem);
      }
      break;
    case K_POST: if (!KEN(K_POST)) break; post_phase(p); break;
    case K_ATTN: if (!KEN(K_ATTN)) break; attn_phase(p, smem); break;
    case K_WOUT: if (!KEN(K_WOUT)) break; fe.layer = a0; fe.slot = 5; fe.scale = 1.0f;
      fast_gemm<EPI_RESID>(p, fe, p.H(), D, a0 ? p.Woout() : p.Weout(), D, 4, 1, smem);
      if (a1) ctx_gemm<EPI_RESID>(p, fe, p.H(), D, a0 ? p.Woout() : p.Weout(), D, 0, 16, smem);
      break;
    case K_O1: if (!KEN(K_O1)) break; fe.outb = p.ACT(); fe.ldo = 2048;
      fast_gemm<EPI_PLAIN>(p, fe, p.H(), D, p.Woin(), D, 8, 1, smem);
      ctx_gemm<EPI_PLAIN>(p, fe, p.H(), D, p.Woin(), D, 1024, 16, smem); break;
    case K_CONV: if (!KEN(K_CONV)) break; conv_phase(p); break;
    case K_LRU: if (!KEN(K_LRU)) break; ea.dir = a0; ea.outu = (uint32_t*)p.R();
      gemm_phase<EPI_LRU>(p, ea, p.XC(), D, p.Wlru(a0), 128, NTOK / 256, 16, 1, 0, smem); break;
    case K_SCAN1: if (!KEN(K_SCAN1)) break; scan1_phase(p, a0); break;
    case K_SCAN2: if (!KEN(K_SCAN2)) break; scan2_phase(p, a0, smem); break;
    default: break;
  }
}

__global__ void __launch_bounds__(NTHR) mega(Params p, int ph_lo, int ph_hi) {
  extern __shared__ __attribute__((aligned(16))) char smem[];
  cg::grid_group grid = cg::this_grid();
  volatile LAS3 unsigned* st = (volatile LAS3 unsigned*)((LAS3 unsigned char*)smem + SMEM_BYTES - 16);
  if (threadIdx.x == 0) { st[0] = 0u; st[1] = 0u; }
  if (blockIdx.x == 0) { for (int i = threadIdx.x; i < XCD_BAR_WORDS; i += NTHR) p.bar()[i] = 0u; if (threadIdx.x < 32) p.kmax2()[threadIdx.x] = 0u; }
  __syncthreads();
  XcdBarrier xb; xb.bar = p.bar(); xb.x = xb_xcc_id(); xb.st = st;
#pragma unroll 1
  for (int ph = 0; ph < ph_hi; ++ph) {
    {
      const __attribute__((address_space(4))) char* ka = (const __attribute__((address_space(4))) char*)__builtin_amdgcn_kernarg_segment_ptr();
      asm volatile("" : "+s"(ka));
      const Params& pk = *(const Params*)ka;
      run_phase(pk, ph, smem);
    }
    if (ph + 1 < ph_hi) {
      if (ph == 0) {
        grid.sync();
        if (threadIdx.x == 0) (void)xb_add(&xb.bar[XB_XCNT(xb.x)], 1u);
      } else xcd_barrier(xb);
    }
  }
}

extern "C" void kernel_launch(void* const* d_in, const int* in_sizes, int n_in, void* d_out, int out_size, void* d_ws,
                              size_t ws_size, hipStream_t stream) {
  static int grid_blocks = 0;
  if (grid_blocks == 0) {
    int dev = 0, cus = 0, per_cu = 0;
    hipGetDevice(&dev);
    hipDeviceGetAttribute(&cus, hipDeviceAttributeMultiprocessorCount, dev);
    if (hipFuncSetAttribute((const void*)mega, hipFuncAttributeMaxDynamicSharedMemorySize, SMEM_BYTES) != hipSuccess) {
      fprintf(stderr, "hipFuncSetAttribute failed\n"); grid_blocks = -1; return;
    }
    if (hipOccupancyMaxActiveBlocksPerMultiprocessor(&per_cu, (const void*)mega, NTHR, SMEM_BYTES) != hipSuccess || per_cu < 1) {
      fprintf(stderr, "occupancy query failed (%d)\n", per_cu); grid_blocks = -1; return;
    }
    grid_blocks = cus;
    grid_blocks -= grid_blocks % 8;
  }
  if (grid_blocks < 0) return;

  Params p{};
  const float** ins = (const float**)&p.x;
  for (int i = 0; i < 29; ++i) ins[i] = (const float*)d_in[i];
  p.out = (float*)d_out;
  p.ws = (char*)d_ws;
  if (WS_TOTAL > ws_size) { fprintf(stderr, "workspace too small: need %zu have %zu\n", (size_t)WS_TOTAL, ws_size); return; }

  int lo = 0, hi = NPHASE;
  void* args[] = {&p, &lo, &hi};
  hipError_t e = hipLaunchCooperativeKernel((const void*)mega, dim3(grid_blocks), dim3(NTHR), args, SMEM_BYTES, stream);
  if (e != hipSuccess) fprintf(stderr, "cooperative launch failed: %s (grid %d)\n", hipGetErrorString(e), grid_blocks);
}
```
